# Optimizing an MI355X kernel written in HIP

```python
import jax
import jax.numpy as jnp
from jax import lax
import numpy as np

D_MODEL = 2048
BATCH = 32
SEQ = 256
DEPTH = 2
DEC_BATCH = 8
DEC_SEQ = 1024
PAST_LEN = 512

GRID_W = 64
ROPE_THETA = 10000.0
HEAD_DIM = 128
MIX_W = D_MODEL
MLA_HEADS = 8
MLA_NOPE = 128
MLA_ROPE = 64
MLA_V = 128
MLA_QK = MLA_NOPE + MLA_ROPE
Q_LORA = 512
KV_LORA = 256
NA_HEADS = 4
NA_WIN_H = 8
NA_WIN_W = 16
NA_QCOLS = 16
NA_BAND_W = 32
NA_NCB = GRID_W // NA_QCOLS
GQA_HEADS = 4
GQA_KV_HEADS = 2
GQA_GROUP = GQA_HEADS // GQA_KV_HEADS
D_FF = 5632
Q_BLOCK = 128
EPS = 1e-6
NEG_INF = -1e30
N_MOD = 9
_S1 = Q_LORA
_S2 = _S1 + KV_LORA
_S3 = _S2 + MLA_ROPE
_S4 = _S3 + 3 * NA_HEADS * HEAD_DIM
_S5 = _S4 + GQA_HEADS * HEAD_DIM
IN_COLS = _S5 + 2 * GQA_KV_HEADS * HEAD_DIM
IN_SPLITS = (_S1, _S2, _S3, _S4, _S5)

kernel_name = 'hybrid_prefix_diffusion_step'


def rms_norm(x, g):
    xf = x.astype(jnp.float32)
    y = xf * lax.rsqrt(jnp.mean(xf * xf, axis=-1, keepdims=True) + EPS)
    return (y * g.astype(jnp.float32)).astype(x.dtype)


def axial_rope(x):
    B, S, H, d = x.shape
    quarter = d // 4
    t = jnp.arange(S)
    pos = jnp.stack([t // GRID_W, t % GRID_W], axis=-1).astype(jnp.float32)
    inv = ROPE_THETA ** (-jnp.arange(quarter, dtype=jnp.float32) / quarter)
    ang = pos[:, :, None] * inv
    cos = jnp.cos(ang)[None, :, None]
    sin = jnp.sin(ang)[None, :, None]
    xr = x.astype(jnp.float32).reshape(B, S, H, 2, 2, quarter)
    x1, x2 = xr[..., 0, :], xr[..., 1, :]
    out = jnp.stack([x1 * cos - x2 * sin, x2 * cos + x1 * sin], axis=-2)
    return out.reshape(B, S, H, d).astype(x.dtype)


def attend(q, k, v):
    B, Sq, Hk, G, Dk = q.shape
    nb = Sq // Q_BLOCK
    scale = Dk ** -0.5
    qb = jnp.moveaxis(q.reshape(B, nb, Q_BLOCK, Hk, G, Dk), 1, 0)

    def one_block(qi):
        s = jnp.einsum('bqhgd,bkhd->bhgqk', qi, k).astype(jnp.float32) * scale
        p = jax.nn.softmax(s, axis=-1).astype(v.dtype)
        return jnp.einsum('bhgqk,bkhe->bqhge', p, v)

    o = lax.map(one_block, qb)
    return jnp.moveaxis(o, 0, 1).reshape(B, Sq, Hk * G, v.shape[-1])


def neighbourhood_attention(q, k, v, k_ctx, v_ctx, rpb):
    B, S, H, D = q.shape
    rows = S // GRID_W
    wh = min(NA_WIN_H, rows)
    nk = wh * NA_BAND_W
    scale = D ** -0.5
    r = jnp.arange(rows)
    row_start = jnp.clip(r - wh // 2, 0, rows - wh)
    key_rows = row_start[:, None] + jnp.arange(wh)
    q_cols = jnp.arange(GRID_W).reshape(NA_NCB, NA_QCOLS)
    band_start = jnp.clip(q_cols[:, 0] - NA_WIN_W // 2, 0, GRID_W - NA_BAND_W)
    key_cols = band_start[:, None] + jnp.arange(NA_BAND_W)
    col_start = jnp.clip(q_cols - NA_WIN_W // 2, 0, GRID_W - NA_WIN_W)
    kc = key_cols[:, None, :]
    valid = (kc >= col_start[:, :, None]) & (kc < col_start[:, :, None] + NA_WIN_W)
    dr = key_rows - r[:, None] + (NA_WIN_H - 1)
    dc = jnp.clip(kc - q_cols[:, :, None] + (NA_WIN_W - 1), 0, 2 * NA_WIN_W - 2)
    bias = rpb[:, dr[:, None, None, :, None], dc[None, :, :, None, :]]
    bias = jnp.where(valid[None, None, :, :, None, :], bias.astype(jnp.float32), NEG_INF)
    bias = bias.reshape(H, rows, NA_NCB, NA_QCOLS, nk).transpose(1, 2, 0, 3, 4)
    ridx = key_rows[:, None, :, None]
    cidx = key_cols[None, :, None, :]
    kb = k.reshape(B, rows, GRID_W, H, D)[:, ridx, cidx].reshape(B, rows, NA_NCB, nk, H, D)
    vb = v.reshape(B, rows, GRID_W, H, D)[:, ridx, cidx].reshape(B, rows, NA_NCB, nk, H, D)
    qg = q.reshape(B, rows, NA_NCB, NA_QCOLS, H, D)
    s_loc = jnp.einsum('brcqhd,brckhd->brchqk', qg, kb).astype(jnp.float32) * scale + bias
    s_ctx = jnp.einsum('brcqhd,bphd->brchqp', qg, k_ctx).astype(jnp.float32) * scale
    p = jax.nn.softmax(jnp.concatenate([s_loc, s_ctx], axis=-1), axis=-1).astype(v.dtype)
    o = (jnp.einsum('brchqk,brckhd->brcqhd', p[..., :nk], vb)
         + jnp.einsum('brchqp,bphd->brcqhd', p[..., nk:], v_ctx))
    return o.reshape(B, S, H * D)


def _mixer_inputs(h, lp):
    B, S, _ = h.shape
    c_q, c_kv, k_rope, na_qkv, g_q, g_kv = jnp.split(h @ lp['w_in'], IN_SPLITS, axis=-1)
    q_mla = (rms_norm(c_q, lp['mla_q_norm']) @ lp['mla_wqb']).reshape(B, S, MLA_HEADS, MLA_QK)
    c_kv = rms_norm(c_kv, lp['mla_kv_norm'])
    na_qkv = na_qkv.reshape(B, S, 3, NA_HEADS, HEAD_DIM)
    g_q = rms_norm(g_q.reshape(B, S, GQA_HEADS, HEAD_DIM), lp['gqa_q_norm'])
    g_kv = g_kv.reshape(B, S, 2, GQA_KV_HEADS, HEAD_DIM)
    g_k = rms_norm(g_kv[:, :, 0], lp['gqa_k_norm'])
    return (q_mla, c_kv, k_rope, na_qkv[:, :, 0], na_qkv[:, :, 1], na_qkv[:, :, 2],
            g_q, g_k, g_kv[:, :, 1])


def _mla_kv(c_kv, k_rope, w_kvb):
    B, S, _ = c_kv.shape
    kv = (c_kv @ w_kvb).reshape(B, S, MLA_HEADS, MLA_NOPE + MLA_V)
    k = jnp.concatenate([kv[..., :MLA_NOPE],
                         jnp.broadcast_to(k_rope[:, :, None, :], (B, S, MLA_HEADS, MLA_ROPE))], axis=-1)
    return k, kv[..., MLA_NOPE:]


def _context_mixer(h, lp):
    B, S, _ = h.shape
    q_mla, c_kv, k_rope, na_q, na_k, na_v, g_q, g_k, g_v = _mixer_inputs(h, lp)
    k_mla, v_mla = _mla_kv(c_kv, k_rope, lp['mla_wkvb'])
    o_a = attend(q_mla[:, :, :, None], k_mla, v_mla).reshape(B, S, -1)
    o_b = attend(na_q[:, :, :, None], na_k, na_v).reshape(B, S, -1)
    o_c = attend(g_q.reshape(B, S, GQA_KV_HEADS, GQA_GROUP, HEAD_DIM), g_k, g_v).reshape(B, S, -1)
    return jnp.concatenate([o_a, o_b, o_c], axis=-1), (c_kv, k_rope, na_k, na_v, g_k, g_v)


def _latent_mixer(h, lp, caches):
    ckv_c, krope_c, nak_c, nav_c, gk_c, gv_c = caches
    B, S, _ = h.shape
    q_mla, c_kv, k_rope, na_q, na_k, na_v, g_q, g_k, g_v = _mixer_inputs(h, lp)
    q_mla = jnp.concatenate([q_mla[..., :MLA_NOPE], axial_rope(q_mla[..., MLA_NOPE:])], axis=-1)
    k_rope = axial_rope(k_rope[:, :, None, :])[:, :, 0]
    k_mla, v_mla = _mla_kv(jnp.concatenate([ckv_c, c_kv], axis=1),
                           jnp.concatenate([krope_c, k_rope], axis=1), lp['mla_wkvb'])
    o_a = attend(q_mla[:, :, :, None], k_mla, v_mla).reshape(B, S, -1)
    o_b = neighbourhood_attention(na_q, na_k, na_v, nak_c, nav_c, lp['na_rpb'])
    g_q = axial_rope(g_q)
    g_k = axial_rope(g_k)
    o_c = attend(g_q.reshape(B, S, GQA_KV_HEADS, GQA_GROUP, HEAD_DIM),
                 jnp.concatenate([gk_c, g_k], axis=1),
                 jnp.concatenate([gv_c, g_v], axis=1)).reshape(B, S, -1)
    return jnp.concatenate([o_a, o_b, o_c], axis=-1), ()


def _swiglu(h, wg, wu, wd):
    return (jax.nn.silu(h @ wg) * (h @ wu)) @ wd


def _modulation(cond, w, b):
    m = jax.nn.silu(cond) @ w + b
    return jnp.split(m[:, None, :], N_MOD, axis=-1)


def _modulate(x, g, shift, scale):
    return rms_norm(x, g) * (1.0 + scale) + shift


def _block(x, mods, lp, mixer):
    sh1, sc1, g1, sh2, sc2, g2, sh3, sc3, g3 = mods
    h = _modulate(x, lp['norm_g'][0], sh1, sc1)
    x = x + 0.5 * g1 * _swiglu(h, lp['ffn_wg'][0], lp['ffn_wu'][0], lp['ffn_wd'][0])
    o, state = mixer(_modulate(x, lp['norm_g'][1], sh2, sc2))
    x = x + g2 * (o @ lp['w_out'])
    h = _modulate(x, lp['norm_g'][2], sh3, sc3)
    x = x + 0.5 * g3 * _swiglu(h, lp['ffn_wg'][1], lp['ffn_wu'][1], lp['ffn_wd'][1])
    return x, state


def setup_inputs(seed: int = 0) -> dict:
    key = jax.random.key(seed)
    ks = jax.random.split(key, 26)
    f32 = jnp.float32

    def nrm(k, shape, s):
        return jax.random.normal(k, shape, f32) * s

    def gain(k, shape):
        return 1.0 + 0.02 * jax.random.normal(k, shape, f32)

    return {
        'x_prompt': nrm(ks[0], (BATCH, SEQ, D_MODEL), 1.0),
        'x_sample': nrm(ks[1], (DEC_BATCH, DEC_SEQ, D_MODEL), 1.0),
        'cache_mla_ckv': nrm(ks[2], (DEC_BATCH, DEPTH, PAST_LEN, KV_LORA), 1.0),
        'cache_mla_krope': nrm(ks[3], (DEC_BATCH, DEPTH, PAST_LEN, MLA_ROPE), 1.0),
        'cache_na_k': nrm(ks[4], (DEC_BATCH, DEPTH, PAST_LEN, NA_HEADS, HEAD_DIM), 1.0),
        'cache_na_v': nrm(ks[5], (DEC_BATCH, DEPTH, PAST_LEN, NA_HEADS, HEAD_DIM), 1.0),
        'cache_gqa_k': nrm(ks[6], (DEC_BATCH, DEPTH, PAST_LEN, GQA_KV_HEADS, HEAD_DIM), 1.0),
        'cache_gqa_v': nrm(ks[7], (DEC_BATCH, DEPTH, PAST_LEN, GQA_KV_HEADS, HEAD_DIM), 1.0),
        'c': nrm(ks[8], (DEC_BATCH, D_MODEL), 1.0),
        'c_ctx': nrm(ks[9], (D_MODEL,), 1.0),
        'ada_w': nrm(ks[10], (DEPTH, D_MODEL, N_MOD * D_MODEL), 0.5 * D_MODEL ** -0.5),
        'ada_b': nrm(ks[11], (DEPTH, N_MOD * D_MODEL), 0.02),
        'norm_g': gain(ks[12], (DEPTH, 3, D_MODEL)),
        'ffn_wg': nrm(ks[13], (DEPTH, 2, D_MODEL, D_FF), D_MODEL ** -0.5),
        'ffn_wu': nrm(ks[14], (DEPTH, 2, D_MODEL, D_FF), D_MODEL ** -0.5),
        'ffn_wd': nrm(ks[15], (DEPTH, 2, D_FF, D_MODEL), D_FF ** -0.5),
        'w_in': nrm(ks[16], (DEPTH, D_MODEL, IN_COLS), D_MODEL ** -0.5),
        'mla_q_norm': gain(ks[17], (DEPTH, Q_LORA)),
        'mla_wqb': nrm(ks[18], (DEPTH, Q_LORA, MLA_HEADS * MLA_QK), Q_LORA ** -0.5),
        'mla_kv_norm': gain(ks[19], (DEPTH, KV_LORA)),
        'mla_wkvb': nrm(ks[20], (DEPTH, KV_LORA, MLA_HEADS * (MLA_NOPE + MLA_V)), KV_LORA ** -0.5),
        'na_rpb': nrm(ks[21], (DEPTH, NA_HEADS, 2 * NA_WIN_H - 1, 2 * NA_WIN_W - 1), 0.1),
        'gqa_q_norm': gain(ks[22], (DEPTH, HEAD_DIM)),
        'gqa_k_norm': gain(ks[23], (DEPTH, HEAD_DIM)),
        'w_out': nrm(ks[24], (DEPTH, MIX_W, D_MODEL), MIX_W ** -0.5),
        'final_norm': gain(ks[25], (D_MODEL,)),
    }


def reference(x_prompt, x_sample, cache_mla_ckv, cache_mla_krope, cache_na_k, cache_na_v,
              cache_gqa_k, cache_gqa_v, c, c_ctx, ada_w, ada_b, norm_g, ffn_wg, ffn_wu, ffn_wd,
              w_in, mla_q_norm, mla_wqb, mla_kv_norm, mla_wkvb, na_rpb, gqa_q_norm, gqa_k_norm,
              w_out, final_norm):
    xp = x_prompt
    xs = x_sample
    ctx_states = []
    for l in range(DEPTH):
        lp = {
            'norm_g': norm_g[l], 'ffn_wg': ffn_wg[l], 'ffn_wu': ffn_wu[l], 'ffn_wd': ffn_wd[l],
            'w_in': w_in[l], 'mla_q_norm': mla_q_norm[l], 'mla_wqb': mla_wqb[l],
            'mla_kv_norm': mla_kv_norm[l], 'mla_wkvb': mla_wkvb[l], 'na_rpb': na_rpb[l],
            'gqa_q_norm': gqa_q_norm[l], 'gqa_k_norm': gqa_k_norm[l], 'w_out': w_out[l],
        }
        mods_ctx = _modulation(c_ctx[None, :], ada_w[l], ada_b[l])
        xp, st = _block(xp, mods_ctx, lp, lambda h: _context_mixer(h, lp))
        ctx_states.append(st)
        caches = (cache_mla_ckv[:, l], cache_mla_krope[:, l], cache_na_k[:, l], cache_na_v[:, l],
                  cache_gqa_k[:, l], cache_gqa_v[:, l])
        mods_lat = _modulation(c, ada_w[l], ada_b[l])
        xs, _ = _block(xs, mods_lat, lp, lambda h: _latent_mixer(h, lp, caches))
    y_prompt = rms_norm(xp, final_norm)
    y_sample = rms_norm(xs, final_norm)
    new_mla_ckv = jnp.stack([s[0] for s in ctx_states], axis=1)
    new_mla_krope = jnp.stack([s[1] for s in ctx_states], axis=1)
    new_na_k = jnp.stack([s[2] for s in ctx_states], axis=1)
    new_na_v = jnp.stack([s[3] for s in ctx_states], axis=1)
    new_gqa_k = jnp.stack([s[4] for s in ctx_states], axis=1)
    new_gqa_v = jnp.stack([s[5] for s in ctx_states], axis=1)
    return (y_prompt, y_sample, new_mla_ckv, new_mla_krope, new_na_k, new_na_v, new_gqa_k, new_gqa_v)
```

```cpp
#include <hip/hip_runtime.h>
#include <cstdio>
#include <cstdint>
#include <type_traits>
#ifndef MK_ONE_LAUNCH
#define MK_ONE_LAUNCH 1
#endif
namespace pg8 {
#define PG8_LAS __attribute__((address_space(3)))
typedef unsigned short bf16_t;
typedef short bf16x8 __attribute__((ext_vector_type(8)));
typedef float f32x4 __attribute__((ext_vector_type(4)));
typedef unsigned u32x4 __attribute__((ext_vector_type(4)));
constexpr int BM = 256, BK = 64, HALF = 128, HTB = HALF * BK * 2  , STAGE_BYTES = 8 * HTB, NXCD = 8, WGM = 8;

__host__ __device__ __forceinline__ int lds_byte(int r, int c) { const int st = (r >> 4) * 2 + (c >> 5), rr = r & 15, cc = c & 31, ob = rr * 64 + cc * 2; return st * 1024 + (ob ^ (((ob >> 9) & 1) << 5)); }
__host__ __device__ __forceinline__ void stage_rc(int b, int& R, int& C) { const int st = b / 1024, sb = b % 1024, swz = sb ^ (((sb >> 9) & 1) << 5); R = (st >> 1) * 16 + swz / 64; C = (st & 1) * 32 + (swz % 64) / 2; }
__host__ __device__ __forceinline__ int perm32(int rho) { const int n = rho >> 4, i = rho & 15; return 8 * (i >> 2) + 4 * n + (i & 3); }

struct Unit { int pm, pn; };
struct Gemm {
    const bf16_t* A; const bf16_t* Bt; int M, N, K, lda, ldb; size_t kstepA, kstepB;
    __host__ __device__ static Gemm make(const bf16_t* A, bool tiledA, int lda, const bf16_t* Bt, bool tiledB, int ldb, int M, int N, int K) {
        Gemm g; g.A = A; g.Bt = Bt; g.M = M; g.N = N; g.K = K; g.lda = tiledA ? 64 : lda; g.ldb = tiledB ? 64 : ldb; g.kstepA = tiledA ? (size_t)M * 128 : 128; g.kstepB = tiledB ? (size_t)N * 128 : 128; return g; }
};

struct StaticOrder {
    int nM, nN, nwg, G, c; bool mixm = false;
    __host__ __device__ void init(int M, int N, int G_, int c_) { nM = M / BM; nN = N / BM; nwg = nM * nN; G = G_; c = c_; }
    __host__ __device__ bool next(int i, Unit& u) const {
        const long L = (long)i * G + c; if (L >= nwg) return false;
        int wgid = (int)L; { const int q = nwg / NXCD, r = nwg % NXCD, xcd = wgid % NXCD, off = wgid / NXCD; wgid = (xcd < r ? xcd * (q + 1) : r * (q + 1) + (xcd - r) * q) + off; }
        const int nig = WGM * nN, gid = wgid / nig, fm = gid * WGM, gsz = (nM - fm) < WGM ? (nM - fm) : WGM;
        u.pm = fm + ((wgid % nig) % gsz); u.pn = (wgid % nig) / gsz;
        if (mixm && (i & 1)) u.pm = (u.pm + (nM >> 1)) % nM;
        return true;
    }
    __device__ __forceinline__ void a_ready(const Unit&) const {}
    __device__ __forceinline__ void done(const Unit&) const {}
};
__device__ __forceinline__ unsigned cvt_pk_bf16(float lo, float hi) { unsigned r; asm volatile("v_cvt_pk_bf16_f32 %0, %1, %2" : "=v"(r) : "v"(lo), "v"(hi)); return r; }
template <class Epi, class Sched, bool ALIGN_EPI = false, bool SP2 = false>
__device__ __forceinline__ void gemm_phase(PG8_LAS unsigned char* lds, const Gemm g, const Sched& S, const Epi& E) {
    int tid_ = threadIdx.x; asm volatile("" : "+v"(tid_));
    const int tid = tid_, wid = __builtin_amdgcn_readfirstlane(tid >> 6), lane = tid & 63, wr = wid >> 2, wc = wid & 3, fr = lane & 15, fq = lane >> 4;
    const int K = g.K, nt = K / BK;
    unsigned voffA[2], voffB[2];
#pragma unroll
    for (int i = 0; i < 2; ++i) { int R, C; stage_rc(tid * 16 + i * 8192, R, C); const int Rb = Epi::PERM ? ((R & ~31) + perm32(R & 31)) : R;
        voffA[i] = (unsigned)(R * g.lda + C) * 2u; voffB[i] = (unsigned)(Rb * g.ldb + C) * 2u; }
    const size_t kstepA = g.kstepA, kstepB = g.kstepB;
    const size_t hstepA = (size_t)HALF * g.lda * 2, hstepB = (size_t)HALF * g.ldb * 2;
    const size_t tstepA = 2 * hstepA, tstepB = 2 * hstepB;
    const unsigned ldsw = (unsigned)wid * 1024u;
    const int aoff = lds_byte(wr * 64 + fr, fq * 8), boff = lds_byte(wc * 32 + fr, fq * 8);
#define PG8_SA(b, h) (((b) * 2 + (h)) * HTB)
#define PG8_SB(b, h) ((4 + (b) * 2 + (h)) * HTB)
#define PG8_STAGE(bufoff, gbase, voff) do { _Pragma("unroll") for (int _i = 0; _i < 2; ++_i) \
        __builtin_amdgcn_global_load_lds((const unsigned*)((const char*)(gbase) + (voff)[_i]), (PG8_LAS unsigned*)(lds + (bufoff) + ldsw + _i * 8192), 16, 0, 0); } while (0)
#define PG8_LDA(dst, b, h) do { _Pragma("unroll") for (int m = 0; m < 4; ++m) _Pragma("unroll") for (int k = 0; k < 2; ++k) dst[m][k] = *(const PG8_LAS bf16x8*)(lds + PG8_SA(b, h) + aoff + m * 2048 + k * 1024); } while (0)
#define PG8_LDB(dst, b, h) do { _Pragma("unroll") for (int n = 0; n < 2; ++n) _Pragma("unroll") for (int k = 0; k < 2; ++k) dst[n][k] = *(const PG8_LAS bf16x8*)(lds + PG8_SB(b, h) + boff + n * 2048 + k * 1024); } while (0)
#define PG8_MMA(ai, bj, At, Bt) do { __builtin_amdgcn_s_setprio(1); _Pragma("unroll") for (int m = 0; m < 4; ++m) _Pragma("unroll") for (int n = 0; n < 2; ++n) _Pragma("unroll") for (int k = 0; k < 2; ++k) \
        acc[ai][bj][m][n] = __builtin_amdgcn_mfma_f32_16x16x32_bf16(Bt[n][k], At[m][k], acc[ai][bj][m][n], 0, 0, 0); __builtin_amdgcn_s_setprio(0); } while (0)
#define PG8_WAIT_V(n) asm volatile("s_waitcnt vmcnt(" #n ")" ::: "memory")
#define PG8_WAIT_L(n) asm volatile("s_waitcnt lgkmcnt(" #n ")" ::: "memory")
#define PG8_BAR __builtin_amdgcn_s_barrier()
#define PG8_SCHED __builtin_amdgcn_sched_barrier(0)
    Unit cur, nxt; int ui = 0;
    if (!S.next(0, cur)) return;
    f32x4 acc[2][2][4][2];
#pragma unroll
    for (int a = 0; a < 2; ++a)
#pragma unroll
        for (int b = 0; b < 2; ++b)
#pragma unroll
            for (int m = 0; m < 4; ++m)
#pragma unroll
                for (int n = 0; n < 2; ++n) acc[a][b][m][n] = (f32x4){0.f, 0.f, 0.f, 0.f};
    bf16x8 At[4][2], B0[2][2], B1[2][2];
    const char* cA = (const char*)g.A + (size_t)cur.pm * tstepA; const char* cB = (const char*)g.Bt + (size_t)cur.pn * tstepB;
    S.a_ready(cur);
    if constexpr (SP2) {
        PG8_STAGE(PG8_SB(0, 0), cB, voffB); PG8_STAGE(PG8_SB(0, 1), cB + hstepB, voffB); PG8_STAGE(PG8_SA(0, 0), cA, voffA); PG8_STAGE(PG8_SA(0, 1), cA + hstepA, voffA);
        if (wr == 1) PG8_BAR;
        PG8_WAIT_V(2); PG8_BAR;
        PG8_STAGE(PG8_SB(1, 0), cB + kstepB, voffB); PG8_STAGE(PG8_SA(1, 0), cA + kstepA, voffA); PG8_STAGE(PG8_SB(1, 1), cB + hstepB + kstepB, voffB);
        PG8_WAIT_V(6); PG8_BAR;
    } else {
        PG8_STAGE(PG8_SB(0, 0), cB, voffB); PG8_STAGE(PG8_SA(0, 0), cA, voffA); PG8_STAGE(PG8_SB(0, 1), cB + hstepB, voffB); PG8_STAGE(PG8_SA(0, 1), cA + hstepA, voffA);
        if (wr == 1) PG8_BAR;
        PG8_WAIT_V(4); PG8_BAR;
        PG8_STAGE(PG8_SB(1, 0), cB + kstepB, voffB); PG8_STAGE(PG8_SA(1, 0), cA + kstepA, voffA); PG8_STAGE(PG8_SB(1, 1), cB + hstepB + kstepB, voffB);
        PG8_WAIT_V(6); PG8_BAR;
    }
    for (;;) {
        const bool has_next = S.next(ui + 1, nxt);
        const char* nA = has_next ? (const char*)g.A + (size_t)nxt.pm * tstepA : cA; const char* nB = has_next ? (const char*)g.Bt + (size_t)nxt.pn * tstepB : cB;
        for (int t = 0; t < nt; t += 2) {
            const bool last = (t == nt - 2);
            const char* a1 = cA + (size_t)(t + 1) * kstepA;
            const char* a2 = last ? nA : cA + (size_t)(t + 2) * kstepA; const char* b2 = last ? nB : cB + (size_t)(t + 2) * kstepB;
            const char* a3 = a2 + kstepA; const char* b3 = b2 + kstepB;
            if (last && has_next) S.a_ready(nxt);
            if constexpr (SP2) {
            PG8_LDB(B0, 0, 0); PG8_LDB(B1, 0, 1); PG8_SCHED; PG8_LDA(At, 0, 0); PG8_STAGE(PG8_SA(1, 1), a1 + hstepA, voffA);
            PG8_WAIT_V(8); PG8_WAIT_L(0); PG8_BAR; PG8_MMA(0, 0, At, B0); PG8_MMA(0, 1, At, B1); PG8_BAR; PG8_SCHED;
            PG8_LDA(At, 0, 1); PG8_STAGE(PG8_SB(0, 0), b2, voffB); PG8_STAGE(PG8_SB(0, 1), b2 + hstepB, voffB); PG8_STAGE(PG8_SA(0, 0), a2, voffA);
            PG8_WAIT_V(8); PG8_WAIT_L(0); PG8_BAR; PG8_MMA(1, 0, At, B0); PG8_MMA(1, 1, At, B1); PG8_BAR; PG8_SCHED;
            PG8_LDB(B0, 1, 0); PG8_LDB(B1, 1, 1); PG8_SCHED; PG8_LDA(At, 1, 0); PG8_STAGE(PG8_SA(0, 1), a2 + hstepA, voffA);
            PG8_WAIT_V(8); PG8_WAIT_L(0); PG8_BAR; PG8_MMA(0, 0, At, B0); PG8_MMA(0, 1, At, B1); PG8_BAR; PG8_SCHED;
            PG8_LDA(At, 1, 1); PG8_STAGE(PG8_SB(1, 0), b3, voffB); PG8_STAGE(PG8_SB(1, 1), b3 + hstepB, voffB); PG8_STAGE(PG8_SA(1, 0), a3, voffA);
            PG8_WAIT_V(8); PG8_WAIT_L(0); PG8_BAR; PG8_MMA(1, 0, At, B0); PG8_MMA(1, 1, At, B1); PG8_BAR; PG8_SCHED;
            } else {
            PG8_LDB(B0, 0, 0); PG8_SCHED; PG8_LDA(At, 0, 0); PG8_STAGE(PG8_SA(1, 1), a1 + hstepA, voffA);
            PG8_WAIT_L(8); PG8_BAR; PG8_WAIT_L(0); PG8_MMA(0, 0, At, B0); PG8_BAR; PG8_SCHED;
            PG8_LDB(B1, 0, 1); PG8_STAGE(PG8_SB(0, 0), b2, voffB);
            PG8_BAR; PG8_WAIT_L(0); PG8_MMA(0, 1, At, B1); PG8_BAR;
            PG8_LDA(At, 0, 1); PG8_STAGE(PG8_SA(0, 0), a2, voffA);
            PG8_BAR; PG8_WAIT_L(0); PG8_MMA(1, 0, At, B0); PG8_BAR; PG8_SCHED;
            PG8_STAGE(PG8_SB(0, 1), b2 + hstepB, voffB);
            PG8_WAIT_V(6); PG8_BAR; PG8_MMA(1, 1, At, B1); PG8_BAR;
            PG8_LDB(B0, 1, 0); PG8_SCHED; PG8_LDA(At, 1, 0); PG8_STAGE(PG8_SA(0, 1), a2 + hstepA, voffA);
            PG8_WAIT_L(8); PG8_BAR; PG8_WAIT_L(0); PG8_MMA(0, 0, At, B0); PG8_BAR; PG8_SCHED;
            PG8_LDB(B1, 1, 1); PG8_STAGE(PG8_SB(1, 0), b3, voffB);
            PG8_BAR; PG8_WAIT_L(0); PG8_MMA(0, 1, At, B1); PG8_BAR;
            PG8_LDA(At, 1, 1); PG8_STAGE(PG8_SA(1, 0), a3, voffA);
            PG8_BAR; PG8_WAIT_L(0); PG8_MMA(1, 0, At, B0); PG8_BAR; PG8_SCHED;
            PG8_STAGE(PG8_SB(1, 1), b3 + hstepB, voffB);
            PG8_WAIT_V(6); PG8_BAR; PG8_MMA(1, 1, At, B1); PG8_BAR;
            }
        }
        if constexpr (ALIGN_EPI) { if (wr == 0) PG8_BAR; }
        if constexpr (!Epi::AFTER_DRAIN) { E(acc, cur, wr, wc, fr, fq); S.done(cur); }
        if (!has_next) break;
#pragma unroll
        for (int a = 0; a < 2; ++a)
#pragma unroll
            for (int b = 0; b < 2; ++b)
#pragma unroll
                for (int m = 0; m < 4; ++m)
#pragma unroll
                    for (int n = 0; n < 2; ++n) acc[a][b][m][n] = (f32x4){0.f, 0.f, 0.f, 0.f};
        cur = nxt; cA = nA; cB = nB; ++ui;
        if constexpr (ALIGN_EPI) { if (wr == 1) PG8_BAR; }
    }
    PG8_WAIT_V(0);
    if constexpr (!ALIGN_EPI) { if (wr == 0) PG8_BAR; }
    PG8_BAR;
    if constexpr (Epi::AFTER_DRAIN) { E.fused(acc, cur, wr, wc, fr, fq, lds, wid, lane); S.done(cur); }
#undef PG8_SA
#undef PG8_SB
#undef PG8_STAGE
#undef PG8_LDA
#undef PG8_LDB
#undef PG8_MMA
#undef PG8_WAIT_V
#undef PG8_WAIT_L
#undef PG8_BAR
#undef PG8_SCHED
}
}

#define GAS __attribute__((address_space(1)))
#define LAS __attribute__((address_space(3)))
typedef unsigned short bf16;
typedef unsigned v4u __attribute__((ext_vector_type(4)));
typedef unsigned v2u __attribute__((ext_vector_type(2)));
typedef float f32x4 __attribute__((ext_vector_type(4)));
typedef float f32x2 __attribute__((ext_vector_type(2)));
typedef short bf16x8 __attribute__((ext_vector_type(8)));
typedef short s16x4 __attribute__((ext_vector_type(4)));
typedef float f32x16 __attribute__((ext_vector_type(16)));

constexpr int DM = 2048, FF = 5632, NTOK = 16384, NCTX = 8192, NIN = 3392, NINP = 3584, NMOD = 18432, NQ = 1536;
constexpr int NKVROWS = 20480;
constexpr float EPS = 1e-6f;
constexpr size_t O_Y = 0, O_CKV = 33554432, O_KR = 37748736, O_NAK = 38797312, O_NAV = 47185920, O_GK = 55574528, O_GV = 59768832;
constexpr size_t MiB = 1u << 20;
constexpr size_t WS_CTL = 0, CTL_ZERO_BYTES = 64 * 1024;
constexpr size_t WS_MODS = 1 * MiB;
constexpr size_t WS_ROPE = 3 * MiB;
constexpr size_t WS_WGU = 4 * MiB;
constexpr size_t WS_WD = 1046 * MiB;
constexpr size_t WS_WIN = 268 * MiB;
constexpr size_t WS_WQB = 296 * MiB;
constexpr size_t WS_WKVB = 299 * MiB;
constexpr size_t WS_WOUT = 301 * MiB;
constexpr size_t WS_X = 317 * MiB;
constexpr size_t WS_H = 445 * MiB;
constexpr size_t WS_ACT = 509 * MiB;
constexpr size_t WS_CQN = 733 * MiB;
constexpr size_t WS_CKVN = 749 * MiB;
constexpr size_t WS_QMLA = 759 * MiB;
constexpr size_t WS_KNC = 807 * MiB;
constexpr size_t WS_VMC = 823 * MiB;
constexpr size_t WS_KRC = 839 * MiB;
constexpr size_t WS_KNL = 840 * MiB;
constexpr size_t WS_VML = 864 * MiB;
constexpr size_t WS_KRL = 888 * MiB;
constexpr size_t WS_NAQ = 890 * MiB;
constexpr size_t WS_NAKC = 906 * MiB;
constexpr size_t WS_NAVC = 914 * MiB;
constexpr size_t WS_NAKL = 922 * MiB;
constexpr size_t WS_NAVL = 934 * MiB;
constexpr size_t WS_GQ = 946 * MiB;
constexpr size_t WS_GKC = 962 * MiB;
constexpr size_t WS_GVC = 966 * MiB;
constexpr size_t WS_GKL = 970 * MiB;
constexpr size_t WS_GVL = 976 * MiB;
constexpr size_t WS_O = 982 * MiB;
constexpr size_t WS_END = 1134 * MiB;
constexpr int CW_Q0 = 256, CW_Q1 = 512;
constexpr int CW_BAR = 4096;
constexpr int LDS_MISC = 131072;
constexpr int LDS_BYTES = 132096;

__device__ __forceinline__ unsigned pk2(float lo, float hi) { unsigned r; asm("v_cvt_pk_bf16_f32 %0, %1, %2" : "=v"(r) : "v"(lo), "v"(hi)); return r; }
__device__ __forceinline__ bf16 f2bf(float f) { unsigned u = __builtin_bit_cast(unsigned, f); return (bf16)((u + 0x7fffu + ((u >> 16) & 1u)) >> 16); }
template <int X> __device__ __forceinline__ float swz_xor(float v) { return __builtin_bit_cast(float, __builtin_amdgcn_ds_swizzle(__builtin_bit_cast(int, v), (X << 10) | 0x1f)); }
__device__ __forceinline__ float half_sum(float v) {
    v += swz_xor<1>(v); v += swz_xor<2>(v); v += swz_xor<4>(v); v += swz_xor<8>(v); v += swz_xor<16>(v); return v;
}
__device__ __forceinline__ float wave_sum(float v) {
    v = half_sum(v);
    const unsigned u = __builtin_bit_cast(unsigned, v); auto rr = __builtin_amdgcn_permlane32_swap(u, u, false, false);
    return __builtin_bit_cast(float, (unsigned)rr[0]) + __builtin_bit_cast(float, (unsigned)rr[1]);
}
__device__ __forceinline__ float dot4(f32x4 a) { return (a.x * a.x + a.y * a.y) + (a.z * a.z + a.w * a.w); }
__device__ __forceinline__ float silu_f(float x) { return x * __builtin_amdgcn_rcpf(1.0f + __builtin_amdgcn_exp2f(-1.4426950408889634f * x)); }
__device__ __forceinline__ f32x4 b4f(v2u w) { f32x4 r; r.x = __builtin_bit_cast(float, w.x << 16); r.y = __builtin_bit_cast(float, w.x & 0xffff0000u); r.z = __builtin_bit_cast(float, w.y << 16); r.w = __builtin_bit_cast(float, w.y & 0xffff0000u); return r; }
__device__ __forceinline__ f32x4 ldb4(const bf16* p) { return b4f(*(const v2u*)p); }
__device__ __forceinline__ float ldb1(const bf16* p) { return __builtin_bit_cast(float, (unsigned)*p << 16); }
__device__ __forceinline__ v2u pk4(f32x4 v) { v2u w; w.x = pk2(v.x, v.y); w.y = pk2(v.z, v.w); return w; }

#ifndef OUT_NT
#define OUT_NT 0
#endif
#if OUT_NT
#define OUT_STORE(p, v) __builtin_nontemporal_store((v), (p))
#else
#define OUT_STORE(p, v) (*(p) = (v))
#endif
struct Args { const float* in[26]; float* out; unsigned char* ws; int ph_lo, ph_hi; };
typedef const __attribute__((address_space(4))) Args* KArgsP;
__device__ __forceinline__ KArgsP kargs() { KArgsP p = (KArgsP)__builtin_amdgcn_kernarg_segment_ptr(); asm volatile("" : "+s"(p)); return p; }
__device__ __forceinline__ unsigned char* ws_base() { return kargs()->ws; }
__device__ __forceinline__ const float* in_ptr(int i) { return kargs()->in[i]; }
#define WSP(T, off) ((T*)(ws_base() + (off)))
#define INP(i) in_ptr(i)
#define OUTP() (kargs()->out)
__device__ __forceinline__ int opaque_bx() { int t = blockIdx.x; asm volatile("" : "+s"(t)); return t; }
__device__ __forceinline__ int opaque_tid() { int t = threadIdx.x; asm volatile("" : "+v"(t)); return t; }
enum { I_XP = 0, I_XS, I_CCKV, I_CKR, I_CNAK, I_CNAV, I_CGK, I_CGV, I_C, I_CCTX, I_ADAW, I_ADAB, I_NORMG, I_WG, I_WU, I_WD, I_WIN, I_QNORM, I_WQB, I_KVNORM, I_WKVB, I_RPB, I_GQN, I_GKN, I_WOUT, I_FNORM };

#ifndef ACT_NT
#define ACT_NT 1
#endif
#if ACT_NT
#define ACT_STORE(p, v) __builtin_nontemporal_store((v), (p))
#else
#define ACT_STORE(p, v) (*(p) = (v))
#endif
struct EpiSwiglu {
    static constexpr bool PERM = true, AFTER_DRAIN = false;
    bf16* act;
    __device__ __forceinline__ void operator()(const pg8::f32x4 (&acc)[2][2][4][2], const pg8::Unit& u, int wr, int wc, int fr, int fq) const {
        const int row0 = u.pm * 256 + wr * 64 + fr, col0 = u.pn * 128 + wc * 32 + 8 * fq;
        float zopq = 0.f; asm("" : "+v"(zopq));
#pragma unroll
        for (int ai = 0; ai < 2; ++ai)
#pragma unroll
            for (int m = 0; m < 4; ++m) {
                const pg8::f32x4 t0 = acc[ai][0][m][0], t1 = acc[ai][0][m][1], u0 = acc[ai][1][m][0], u1 = acc[ai][1][m][1];
                float e[8], y[8];
#pragma unroll
                for (int j = 0; j < 4; ++j) { e[j] = __builtin_amdgcn_exp2f(t0[j]); e[4 + j] = __builtin_amdgcn_exp2f(t1[j]); }
#pragma unroll
                for (int j = 0; j < 8; ++j) e[j] = e[j] + 1.0f;
#pragma unroll
                for (int j = 0; j < 8; ++j) e[j] = __builtin_amdgcn_rcpf(e[j]);
#pragma unroll
                for (int j = 0; j < 4; ++j) { const float p0 = (j & 1) ? __builtin_fmaf(t0[j], u0[j], zopq) : t0[j] * u0[j], p1 = (j & 1) ? __builtin_fmaf(t1[j], u1[j], zopq) : t1[j] * u1[j]; y[j] = p0 * e[j]; y[4 + j] = p1 * e[4 + j]; }
                v4u w; w.x = pk2(y[0], y[1]); w.y = pk2(y[2], y[3]); w.z = pk2(y[4], y[5]); w.w = pk2(y[6], y[7]);
                ACT_STORE((v4u*)(act + ((size_t)(col0 >> 6) * NTOK + (row0 + ai * 128 + m * 16)) * 64 + (col0 & 63)), w);
            }
    }
};
#ifndef X_NT
#define X_NT 1
#endif
#if X_NT
#define X_STORE(p, v) __builtin_nontemporal_store((v), (p))
#else
#define X_STORE(p, v) (*(p) = (v))
#endif
struct EpiResid {
    static constexpr bool PERM = true, AFTER_DRAIN = false;
    const bf16* xin; bf16* xout; const float* gate; float fac;
    __device__ __forceinline__ void operator()(const pg8::f32x4 (&acc)[2][2][4][2], const pg8::Unit& u, int wr, int wc, int fr, int fq) const {
        const int row0 = u.pm * 256 + wr * 64 + fr, col0 = u.pn * 256 + wc * 32 + 8 * fq;
        const int cb = u.pm < 32 ? 8 : ((u.pm - 32) >> 2);
        const float* gp = gate + (size_t)cb * NMOD + col0;
        pg8::f32x4 gv[2][2];
#pragma unroll
        for (int bj = 0; bj < 2; ++bj)
#pragma unroll
            for (int n = 0; n < 2; ++n) gv[bj][n] = *(const pg8::f32x4*)(gp + bj * 128 + 4 * n) * fac;
#pragma unroll
        for (int ai = 0; ai < 2; ++ai) {
            v4u xv[4][2];
#pragma unroll
            for (int m = 0; m < 4; ++m) { const size_t off = (size_t)(row0 + ai * 128 + m * 16) * DM + col0;
#pragma unroll
                for (int bj = 0; bj < 2; ++bj) xv[m][bj] = *(const v4u*)(xin + off + bj * 128); }
#pragma unroll
            for (int m = 0; m < 4; ++m) { const size_t off = (size_t)(row0 + ai * 128 + m * 16) * DM + col0;
#pragma unroll
                for (int bj = 0; bj < 2; ++bj) { const v4u x = xv[m][bj];
                    const pg8::f32x4 y0 = b4f((v2u){x.x, x.y}) + gv[bj][0] * acc[ai][bj][m][0], y1 = b4f((v2u){x.z, x.w}) + gv[bj][1] * acc[ai][bj][m][1];
                    v4u w; w.x = pk2(y0[0], y0[1]); w.y = pk2(y0[2], y0[3]); w.z = pk2(y1[0], y1[1]); w.w = pk2(y1[2], y1[3]);
                    X_STORE((v4u*)(xout + off + bj * 128), w); } }
        }
    }
};
struct EpiMix {
    static constexpr bool PERM = true, AFTER_DRAIN = false;
    bf16* C; int ldc;
    bf16 *naq, *nakC, *navC, *nakL, *navL, *gvC, *gvL; float *oNAK, *oNAV, *oGV;
    __device__ __forceinline__ void operator()(const pg8::f32x4 (&acc)[2][2][4][2], const pg8::Unit& u, int wr, int wc, int fr, int fq) const {
        const int r0 = wr * 64 + fr, cw = wc * 32 + 8 * fq;
        const bool ctx = u.pm < 32; const int q = u.pm - 32;
        const size_t grow0 = (size_t)u.pm * 256;
        const size_t lrow0 = ctx ? 0 : (size_t)(q >> 2) * 1536 + 512 + (size_t)(q & 3) * 256;
        const size_t orow0 = (size_t)u.pm * 512;
        const int pn = u.pn;
        int kind = 0; bf16* bdst = C; float* odst = nullptr; int width = ldc, cbase = pn * 256; size_t brow0 = grow0;
        if (pn >= 3 && pn <= 4) { kind = 1; bdst = naq; width = 512; cbase = (pn - 3) * 256; }
        else if (pn >= 5 && pn <= 6) { kind = 2; bdst = ctx ? nakC : nakL; odst = oNAK; width = 512; cbase = (pn - 5) * 256; brow0 = ctx ? grow0 : lrow0; }
        else if (pn >= 7 && pn <= 8) { kind = 2; bdst = ctx ? navC : navL; odst = oNAV; width = 512; cbase = (pn - 7) * 256; brow0 = ctx ? grow0 : lrow0; }
        else if (pn == 12) { kind = 2; bdst = ctx ? gvC : gvL; odst = oGV; width = 256; cbase = 0; brow0 = ctx ? grow0 : lrow0; }
#pragma unroll
        for (int ai = 0; ai < 2; ++ai)
#pragma unroll
            for (int m = 0; m < 4; ++m) {
                const int r = r0 + ai * 128 + m * 16;
                bf16* rowp = bdst + (brow0 + r) * width + cbase + cw;
#pragma unroll
                for (int bj = 0; bj < 2; ++bj) { const pg8::f32x4 v0 = acc[ai][bj][m][0], v1 = acc[ai][bj][m][1];
                    v4u w; w.x = pk2(v0[0], v0[1]); w.y = pk2(v0[2], v0[3]); w.z = pk2(v1[0], v1[1]); w.w = pk2(v1[2], v1[3]);
                    *(v4u*)(rowp + bj * 128) = w;
                    if (kind == 2 && ctx) { float* op = odst + (orow0 + r) * width + cbase + cw + bj * 128; OUT_STORE((pg8::f32x4*)op, v0); OUT_STORE((pg8::f32x4*)(op + 4), v1); } }
            }
    }
};
struct EpiQRope {
    static constexpr bool PERM = true, AFTER_DRAIN = false;
    bf16* Q; const f32x2* r64;
    __device__ __forceinline__ void operator()(const pg8::f32x4 (&acc)[2][2][4][2], const pg8::Unit& u, int wr, int wc, int fr, int fq) const {
        const int row0 = u.pm * 256 + wr * 64 + fr;
#pragma unroll
        for (int bj = 0; bj < 2; ++bj) {
            const int c8 = u.pn * 256 + bj * 128 + wc * 32 + 8 * fq, h = c8 / 192, d = c8 - h * 192;
            const bool rope = (d >= 128) && (u.pm >= 32);
            const int j0 = d - 128, a = j0 >> 5, i0 = (j0 & 31) >> 1;
            pg8::f32x4 cs[2][4][2];
            if (rope) {
#pragma unroll
                for (int ai = 0; ai < 2; ++ai)
#pragma unroll
                    for (int m = 0; m < 4; ++m) { const int t = (row0 + ai * 128 + m * 16 - NCTX) & 1023, pos = a ? (t & 63) : (t >> 6);
                        const pg8::f32x4* tp = (const pg8::f32x4*)(r64 + pos * 16 + i0); cs[ai][m][0] = tp[0]; cs[ai][m][1] = tp[1]; }
            }
#pragma unroll
            for (int ai = 0; ai < 2; ++ai)
#pragma unroll
                for (int m = 0; m < 4; ++m) {
                    const int row = row0 + ai * 128 + m * 16;
                    pg8::f32x4 v0 = acc[ai][bj][m][0], v1 = acc[ai][bj][m][1];
                    if (rope) {
                        const pg8::f32x4 c01 = cs[ai][m][0], c23 = cs[ai][m][1];
                        pg8::f32x4 y0, y1;
                        y0[0] = v0[0] * c01[0] - v0[1] * c01[1]; y0[1] = v0[1] * c01[0] + v0[0] * c01[1];
                        y0[2] = v0[2] * c01[2] - v0[3] * c01[3]; y0[3] = v0[3] * c01[2] + v0[2] * c01[3];
                        y1[0] = v1[0] * c23[0] - v1[1] * c23[1]; y1[1] = v1[1] * c23[0] + v1[0] * c23[1];
                        y1[2] = v1[2] * c23[2] - v1[3] * c23[3]; y1[3] = v1[3] * c23[2] + v1[2] * c23[3];
                        v0 = y0; v1 = y1;
                    }
                    v4u w; w.x = pk2(v0[0], v0[1]); w.y = pk2(v0[2], v0[3]); w.z = pk2(v1[0], v1[1]); w.w = pk2(v1[2], v1[3]);
                    *(v4u*)(Q + (size_t)row * NQ + c8) = w;
                }
        }
    }
};
struct EpiKV {
    static constexpr bool PERM = true, AFTER_DRAIN = false;
    bf16 *knC, *vC, *knL, *vL;
    __device__ __forceinline__ void operator()(const pg8::f32x4 (&acc)[2][2][4][2], const pg8::Unit& u, int wr_, int wc_, int fr_, int fq_) const {
        const int t2 = opaque_tid(), wid2 = __builtin_amdgcn_readfirstlane(t2 >> 6), wr = wid2 >> 2, wc = wid2 & 3, fr = t2 & 15, fq = (t2 & 63) >> 4;
        (void)wr_; (void)wc_; (void)fr_; (void)fq_;
        bf16 *kb, *vb; int drow0;
        if (u.pm < 32) { kb = knC; vb = vC; drow0 = u.pm * 256; }
        else if (u.pm < 64) { const int q = u.pm - 32; kb = knL; vb = vL; drow0 = (q >> 2) * 1536 + 512 + (q & 3) * 256; }
        else { const int q = u.pm - 64; kb = knL; vb = vL; drow0 = (q >> 1) * 1536 + (q & 1) * 256; }
        const int col0 = u.pn * 128 + wc * 32 + 8 * fq;
#pragma unroll
        for (int ai = 0; ai < 2; ++ai)
#pragma unroll
            for (int m = 0; m < 4; ++m) {
                const size_t off = (size_t)(drow0 + wr * 64 + fr + ai * 128 + m * 16) * 1024 + col0;
#pragma unroll
                for (int bj = 0; bj < 2; ++bj) {
                    const pg8::f32x4 v0 = acc[ai][bj][m][0], v1 = acc[ai][bj][m][1];
                    v4u w; w.x = pk2(v0[0], v0[1]); w.y = pk2(v0[2], v0[3]); w.z = pk2(v1[0], v1[1]); w.w = pk2(v1[2], v1[3]);
                    *(v4u*)((bj ? vb : kb) + off) = w;
                }
            }
    }
};

namespace att {
constexpr float THR = 8.f;
constexpr int SHM_V = 16384, SHM_K = 16384, SHM_R = 8192;
constexpr int OFF_V = 0, OFF_K = 32768, OFF_R = 65536, OFF_WS = 81920, OFF_T = 83968, OFF_PEN = 91648, OFF_BC = 92160, OFF_QR = 92672;
#define KSWZ(row, colB) ((row) * 256 + ((colB) ^ (((row) & 7) << 4)))
#define RSWZ(row, colB) ((row) * 128 + ((colB) ^ (((row) & 7) << 4)))
#define SBAR() __builtin_amdgcn_sched_barrier(0)
__device__ __forceinline__ int crow(int r, int hi) { return (r & 3) + 8 * (r >> 2) + 4 * hi; }
__device__ __forceinline__ unsigned cvtpk(float lo, float hi) { unsigned r; asm volatile("v_cvt_pk_bf16_f32 %0, %1, %2" : "=v"(r) : "v"(lo), "v"(hi)); return r; }

template <int DK> __device__ __forceinline__ void partialSM(f32x16& p0, f32x16& p1, float& m_reg, float& mn, float& alpha) {
  constexpr float SCALE = (DK == 192) ? 0.07216878364870323f : 0.08838834764831845f;
  constexpr float C = SCALE * 1.4426950408889634f;
  float pmax = p0[0];
#pragma unroll
  for (int r = 1; r < 16; ++r) pmax = fmaxf(pmax, p0[r]);
#pragma unroll
  for (int r = 0; r < 16; ++r) pmax = fmaxf(pmax, p1[r]);
  { auto rr = __builtin_amdgcn_permlane32_swap(__float_as_uint(pmax), __float_as_uint(pmax), false, false);
    pmax = fmaxf(__uint_as_float(rr[0]), __uint_as_float(rr[1])); }
  if (__builtin_expect(__all(pmax - m_reg <= THR / SCALE), 1)) { mn = m_reg; alpha = 1.f; }
  else { mn = fmaxf(m_reg, pmax); alpha = __builtin_amdgcn_exp2f((m_reg - mn) * C); m_reg = mn; }
  const float mnC = -mn * C;
#pragma unroll
  for (int r = 0; r < 16; ++r) p0[r] = fmaf(p0[r], C, mnC);
#pragma unroll
  for (int r = 0; r < 16; ++r) p1[r] = fmaf(p1[r], C, mnC);
#pragma unroll
  for (int r = 0; r < 16; ++r) p0[r] = __builtin_amdgcn_exp2f(p0[r]);
}
__device__ __forceinline__ void finishSM(f32x16& p0, f32x16& p1, float alpha, float& l_reg, bf16x8& pa0, bf16x8& pa1, bf16x8& pa2, bf16x8& pa3) {
#pragma unroll
  for (int r = 0; r < 16; ++r) p1[r] = __builtin_amdgcn_exp2f(p1[r]);
  float ps = 0;
#pragma unroll
  for (int r = 0; r < 16; ++r) ps += p0[r];
#pragma unroll
  for (int r = 0; r < 16; ++r) ps += p1[r];
  { auto rr = __builtin_amdgcn_permlane32_swap(__float_as_uint(ps), __float_as_uint(ps), false, false);
    ps = __uint_as_float(rr[0]) + __uint_as_float(rr[1]); }
  l_reg = l_reg * alpha + ps;
#define PK4(P, BASE, OUT) do { unsigned a0 = cvtpk(P[BASE + 0], P[BASE + 1]), a1 = cvtpk(P[BASE + 2], P[BASE + 3]);   \
    unsigned b0 = cvtpk(P[BASE + 4], P[BASE + 5]), b1 = cvtpk(P[BASE + 6], P[BASE + 7]);                              \
    auto r0 = __builtin_amdgcn_permlane32_swap(a0, b0, false, false); auto r1 = __builtin_amdgcn_permlane32_swap(a1, b1, false, false); \
    v4u w = {r0[0], r1[0], r0[1], r1[1]}; OUT = *reinterpret_cast<bf16x8*>(&w); } while (0)
  PK4(p0, 0, pa0); PK4(p0, 8, pa1); PK4(p1, 0, pa2); PK4(p1, 8, pa3);
#undef PK4
}
template <int DK, int NREG> __device__ __forceinline__ void qkt(f32x16& p0, f32x16& p1, const char* Ks, const char* Rs, const bf16x8* qr, const char* qrl, int r32, int hi) {
  p0 = f32x16{}; p1 = f32x16{};
#pragma unroll
  for (int d0 = 0; d0 < 8; ++d0) { const int cb = (d0 * 16 + hi * 8) * 2;
    const bf16x8 b0 = *reinterpret_cast<const bf16x8*>(Ks + KSWZ(r32, cb));
    const bf16x8 b1 = *reinterpret_cast<const bf16x8*>(Ks + KSWZ(32 + r32, cb));
    bf16x8 q; if constexpr (true) { if (d0 < NREG) q = qr[d0 < NREG ? d0 : 0]; else q = *reinterpret_cast<const bf16x8*>(qrl + (d0 - NREG) * 1024); }
    p0 = __builtin_amdgcn_mfma_f32_32x32x16_bf16(b0, q, p0, 0, 0, 0);
    p1 = __builtin_amdgcn_mfma_f32_32x32x16_bf16(b1, q, p1, 0, 0, 0); }
  if constexpr (DK == 192) {
#pragma unroll
    for (int d0 = 0; d0 < 4; ++d0) { const int cb = (d0 * 16 + hi * 8) * 2;
      const bf16x8 b0 = *reinterpret_cast<const bf16x8*>(Rs + RSWZ(r32, cb));
      const bf16x8 b1 = *reinterpret_cast<const bf16x8*>(Rs + RSWZ(32 + r32, cb));
      const bf16x8 q = *reinterpret_cast<const bf16x8*>(qrl + (8 + d0 - NREG) * 1024);
      p0 = __builtin_amdgcn_mfma_f32_32x32x16_bf16(b0, q, p0, 0, 0, 0);
      p1 = __builtin_amdgcn_mfma_f32_32x32x16_bf16(b1, q, p1, 0, 0, 0); }
  }
}
__device__ __forceinline__ void na_hook(f32x16& p0, f32x16& p1, bool row_ok, const float* Trow, const float* Prow) {
  if (!row_ok) {
#pragma unroll
    for (int r = 0; r < 16; ++r) { p0[r] = -1e30f; p1[r] = -1e30f; }
  } else {
#pragma unroll
    for (int r = 0; r < 16; ++r) { const int kr = (r & 3) + 8 * (r >> 2);
      p0[r] = (p0[r] + Trow[kr]) + Prow[kr];
      p1[r] = (p1[r] + Trow[kr + 32]) + Prow[kr + 32];
      if (r & 1) asm volatile("" ::: "memory"); }
  }
}
__device__ __forceinline__ int v_st(int k, int c) { const int kk = (k & ~0xC) | ((k & 4) << 1) | ((k & 8) >> 1); return ((kk >> 3) * 4 + (c >> 5)) * 512 + ((kk & 7) * 32 + (c & 31)) * 2; }
__device__ __forceinline__ int v_rd_base(int lane) { return ((lane & 3) << 3) | (((lane >> 2) & 3) << 6) | (((lane >> 4) & 1) << 5) | (((lane >> 5) & 1) << 8); }
constexpr int v_rd_off(int d0, int ks, int half) { return d0 * 512 + ks * 4096 + half * 2048; }
template <int OFF> __device__ __forceinline__ s16x4 tr_read(int vb) {
  s16x4 r; asm volatile("ds_read_b64_tr_b16 %0, %1 offset:%2" : "=&v"(r) : "v"(vb), "i"(OFF) : "memory"); return r;
}
template <int D0> __device__ __forceinline__ void pv_one(f32x16& od, int vb, bf16x8 pa0, bf16x8 pa1, bf16x8 pa2, bf16x8 pa3) {
  const s16x4 l0 = tr_read<v_rd_off(D0, 0, 0)>(vb), h0 = tr_read<v_rd_off(D0, 0, 1)>(vb), l1 = tr_read<v_rd_off(D0, 1, 0)>(vb), h1 = tr_read<v_rd_off(D0, 1, 1)>(vb);
  const s16x4 l2 = tr_read<v_rd_off(D0, 2, 0)>(vb), h2 = tr_read<v_rd_off(D0, 2, 1)>(vb), l3 = tr_read<v_rd_off(D0, 3, 0)>(vb), h3 = tr_read<v_rd_off(D0, 3, 1)>(vb);
  asm volatile("s_waitcnt lgkmcnt(0)" ::: "memory"); SBAR();
#define PK(L, H) (bf16x8){L[0], L[1], L[2], L[3], H[0], H[1], H[2], H[3]}
  od = __builtin_amdgcn_mfma_f32_32x32x16_bf16(pa0, PK(l0, h0), od, 0, 0, 0);
  od = __builtin_amdgcn_mfma_f32_32x32x16_bf16(pa1, PK(l1, h1), od, 0, 0, 0);
  od = __builtin_amdgcn_mfma_f32_32x32x16_bf16(pa2, PK(l2, h2), od, 0, 0, 0);
  od = __builtin_amdgcn_mfma_f32_32x32x16_bf16(pa3, PK(l3, h3), od, 0, 0, 0);
#undef PK
}
__device__ __forceinline__ void pv_d0(f32x16* o, int vb, bf16x8 pa0, bf16x8 pa1, bf16x8 pa2, bf16x8 pa3) {
  pv_one<0>(o[0], vb, pa0, pa1, pa2, pa3); pv_one<1>(o[1], vb, pa0, pa1, pa2, pa3); pv_one<2>(o[2], vb, pa0, pa1, pa2, pa3); pv_one<3>(o[3], vb, pa0, pa1, pa2, pa3);
}

template <int DK, bool HOOK, int SD, int NREG>
__device__ __forceinline__ void attn_unit(const bf16* __restrict__ Qb, const int ldq, const bf16* __restrict__ Kh, const int ldk, const bf16* __restrict__ Rh,
                                          const bf16* __restrict__ Vh, bf16* __restrict__ Obase, const int orow0, const int ocol0,
                                          const int NT, const int nplain, const int loc0, const int r0, const int lo, char* lds) {
  int tid_ = threadIdx.x; asm volatile("" : "+v"(tid_));
  const int tid = tid_, wid = tid >> 6, lane = tid & 63, r32 = lane & 31, hi = lane >> 5;
  char* V_lds = lds + OFF_V; char* K_lds = lds + OFF_K; char* R_lds = lds + OFF_R;
  float* ws = (float*)(lds + OFF_WS) + wid * 64; float* li_l = ws; float* al_l = ws + 32;
  float m_reg = -1e30f, l_reg = 0; f32x16 o[4] = {}; bf16x8 qr[NREG];
  const bf16* Qw = Qb + (long)(wid * 32 + r32) * ldq + hi * 8;
  char* qrl = lds + OFF_QR + wid * 4096 + lane * 16;
  static_assert(DK / 16 - NREG <= 4 && NREG <= 8, "at most four Q fragments per lane in LDS");
#pragma unroll
  for (int d0 = 0; d0 < DK / 16; ++d0) { const bf16x8 v = *reinterpret_cast<const bf16x8*>(Qw + d0 * 16);
    if (d0 < NREG) qr[d0 < NREG ? d0 : 0] = v; else *reinterpret_cast<bf16x8*>(qrl + (d0 - NREG) * 1024) = v; }
  const int sr = tid >> 4, sc = (tid & 15) * 8, vst0 = v_st(sr, sc), vst1 = v_st(32 + sr, sc);
  const int rr = tid >> 3, rc = (tid & 7) * 8;
  const unsigned vo0 = (unsigned)(sr * ldk + sc) * 2u, vo1 = vo0 + (unsigned)ldk * 64u, vor = (unsigned)(rr * 64 + rc) * 2u;
  const int vb0 = (int)(uintptr_t)V_lds + v_rd_base(lane);
  const int grow = r0 + (wid >> 1), rs = min(max(grow - 4, 0), 8);
  const int qc = 32 * (wid & 1) + r32, cs = min(max(qc - 8, 0), 48);
  const float* Tlane = (const float*)(lds + OFF_T) + 48 + 15 - qc + 4 * hi;
  const float* Plane = (const float*)(lds + OFF_PEN) + 63 + 4 * hi - cs;
  struct { bf16x8 vs0, vs1, ks0, ks1, rs; } sr_[SD];
  constexpr int SE = 0, SO = SD - 1;
#define KOFF(j) ((j) < nplain ? (j) * 64 : loc0 + ((j) - nplain) * 64)
#define SLOAD(i, j) do { const int k0_ = KOFF(j); const char* kt_ = (const char*)(Kh + (long)k0_ * ldk); const char* vt_ = (const char*)(Vh + (long)k0_ * ldk); \
    sr_[i].vs0 = *reinterpret_cast<const bf16x8*>(vt_ + vo0); sr_[i].vs1 = *reinterpret_cast<const bf16x8*>(vt_ + vo1); \
    sr_[i].ks0 = *reinterpret_cast<const bf16x8*>(kt_ + vo0); sr_[i].ks1 = *reinterpret_cast<const bf16x8*>(kt_ + vo1); \
    if constexpr (DK == 192) sr_[i].rs = *reinterpret_cast<const bf16x8*>((const char*)(Rh + (long)k0_ * 64) + vor); } while (0)
#define SWRITE(b, i) do { *(bf16x8*)(V_lds + (b) * SHM_V + vst0) = sr_[i].vs0; *(bf16x8*)(V_lds + (b) * SHM_V + vst1) = sr_[i].vs1; const int kc_ = sc * 2; \
    *(bf16x8*)(K_lds + (b) * SHM_K + KSWZ(sr, kc_)) = sr_[i].ks0; *(bf16x8*)(K_lds + (b) * SHM_K + KSWZ(32 + sr, kc_)) = sr_[i].ks1; \
    if constexpr (DK == 192) *(bf16x8*)(R_lds + (b) * SHM_R + RSWZ(rr, rc * 2)) = sr_[i].rs; } while (0)
#define SWAIT() do { if constexpr (SD == 1) asm volatile("s_waitcnt vmcnt(0)" ::: "memory"); else if constexpr (DK == 192) asm volatile("s_waitcnt vmcnt(5)" ::: "memory"); else asm volatile("s_waitcnt vmcnt(4)" ::: "memory"); } while (0)
#define RESC(a) do { if (__any((a) < 1.f)) { if (hi == 0) al_l[r32] = (a); asm volatile("s_waitcnt lgkmcnt(0)" ::: "memory"); \
    _Pragma("unroll") for (int d = 0; d < 4; ++d) _Pragma("unroll") for (int r = 0; r < 16; ++r) o[d][r] *= al_l[crow(r, hi)]; } } while (0)
#define HOOKT(p0, p1, j) do { if constexpr (HOOK) { if ((j) >= nplain) { const int kr_ = lo + (j) - nplain; \
    na_hook(p0, p1, kr_ >= rs && kr_ < rs + 8, Tlane + (kr_ - grow + 7) * 128, Plane); } } } while (0)
  f32x16 pA0, pA1, pB0, pB1; float mnA, mnB, alA, alB; bf16x8 pa0, pa1, pa2, pa3;
  SLOAD(SE, 0); asm volatile("s_waitcnt vmcnt(0)" ::: "memory"); SWRITE(0, SE); __syncthreads();
  qkt<DK, NREG>(pA0, pA1, K_lds, R_lds, qr, qrl, r32, hi); partialSM<DK>(pA0, pA1, m_reg, mnA, alA);
  SLOAD(SO, 1); if constexpr (SD == 2) { if (2 < NT) SLOAD(SE, 2); }
  SWAIT(); SWRITE(1, SO); __syncthreads();
  for (int j = 1; j + 1 < NT; j += 2) {
    SBAR(); qkt<DK, NREG>(pB0, pB1, K_lds + SHM_K, R_lds + SHM_R, qr, qrl, r32, hi); HOOKT(pB0, pB1, j);
    finishSM(pA0, pA1, alA, l_reg, pa0, pa1, pa2, pa3); SBAR();
    SLOAD(SO, j + SD); SBAR();
    pv_d0(o, vb0, pa0, pa1, pa2, pa3); partialSM<DK>(pB0, pB1, m_reg, mnB, alB);
    __syncthreads(); SWAIT(); SWRITE(0, SE);
    RESC(alB); __syncthreads();
    SBAR(); qkt<DK, NREG>(pA0, pA1, K_lds, R_lds, qr, qrl, r32, hi); HOOKT(pA0, pA1, j + 1);
    finishSM(pB0, pB1, alB, l_reg, pa0, pa1, pa2, pa3); SBAR();
    if (SD == 1 || j + 3 < NT) SLOAD(SE, j + 1 + SD); SBAR();
    pv_d0(o, vb0 + SHM_V, pa0, pa1, pa2, pa3); partialSM<DK>(pA0, pA1, m_reg, mnA, alA);
    __syncthreads(); SWAIT(); SWRITE(1, SO);
    RESC(alA); __syncthreads();
  }
  SBAR(); qkt<DK, NREG>(pB0, pB1, K_lds + SHM_K, R_lds + SHM_R, qr, qrl, r32, hi); HOOKT(pB0, pB1, NT - 1);
  finishSM(pA0, pA1, alA, l_reg, pa0, pa1, pa2, pa3); SBAR();
  pv_d0(o, vb0, pa0, pa1, pa2, pa3); partialSM<DK>(pB0, pB1, m_reg, mnB, alB);
  __syncthreads(); RESC(alB);
  finishSM(pB0, pB1, alB, l_reg, pa0, pa1, pa2, pa3); SBAR();
  pv_d0(o, vb0 + SHM_V, pa0, pa1, pa2, pa3);
  if (hi == 0) li_l[r32] = l_reg; asm volatile("s_waitcnt lgkmcnt(0)" ::: "memory");
  float rli[16];
#pragma unroll
  for (int r = 0; r < 16; ++r) rli[r] = __builtin_amdgcn_rcpf(li_l[crow(r, hi)]);
  char* ost = lds + OFF_QR + wid * 4096;
#pragma unroll
  for (int h = 0; h < 2; ++h) {
#pragma unroll
    for (int r = 0; r < 16; ++r) { const int row = crow(r, hi);
#pragma unroll
      for (int dd = 0; dd < 2; ++dd) *(bf16*)(ost + row * 128 + (dd * 32 + r32) * 2) = (bf16)cvtpk(o[2 * h + dd][r] * rli[r], 0.f); }
    asm volatile("s_waitcnt lgkmcnt(0)" ::: "memory");
#pragma unroll
    for (int i = 0; i < 4; ++i) { const int c = i * 64 + lane, row = c >> 3, ch = c & 7;
      const v4u v = *(const v4u*)(ost + row * 128 + ch * 16);
      *(v4u*)(Obase + ((size_t)((ocol0 >> 6) + h) * NTOK + (size_t)(orow0 + wid * 32 + row)) * 64 + ch * 8) = v; }
    asm volatile("s_waitcnt lgkmcnt(0)" ::: "memory");
  }
#undef KOFF
#undef SLOAD
#undef SWRITE
#undef SWAIT
#undef RESC
#undef HOOKT
}
}
#define XB_TMO      128
#define XB_XCNT(j)  (256  + 64 * (j))
#define XB_XSUB(j)  (1280 + 64 * (j))
#define XB_XGEN(j)  (2304 + 64 * (j))
#define XB_TOP      3328
#define XB_TOPGEN   3392
#define XCD_BAR_WORDS 3456
#define XB_SPIN_CAP (1u << 18)

__device__ __forceinline__ unsigned xb_ld(unsigned* p)              { return __hip_atomic_load(p, __ATOMIC_RELAXED, __HIP_MEMORY_SCOPE_AGENT); }
__device__ __forceinline__ unsigned xb_add(unsigned* p, unsigned v) { return __hip_atomic_fetch_add(p, v, __ATOMIC_RELAXED, __HIP_MEMORY_SCOPE_AGENT); }
__device__ __forceinline__ unsigned xb_xcc_id() { return (unsigned)__builtin_amdgcn_s_getreg((3 << 11) | 20) & 0xFu; }
#define XB_SPIN(cond, bar) do { unsigned _sp = 0; while (cond) { __builtin_amdgcn_s_sleep(1); \
    if ((++_sp & 255u) == 0u) { if (xb_ld(&(bar)[XB_TMO])) break; if (_sp > XB_SPIN_CAP) { atomicAdd(&(bar)[XB_TMO], 1u); break; } } } } while (0)

struct XcdBarrier {
    unsigned* bar; unsigned x;
    volatile LAS unsigned* st;
};

__device__ __forceinline__ XcdBarrier xcd_barrier_post(unsigned* bar, volatile LAS unsigned* st) {
    XcdBarrier b; b.bar = bar; b.x = xb_xcc_id(); b.st = st;
    if (threadIdx.x == 0) (void)xb_add(&bar[XB_XCNT(b.x)], 1u);
    return b;
}
__device__ __forceinline__ void xcd_barrier_complete(unsigned* bar, unsigned x, unsigned& nloc, unsigned& nx) {
    const unsigned G = gridDim.x * gridDim.y * gridDim.z;
    unsigned sum, cnt, mine, sp = 0u;
    for (;;) {
        sum = 0u; cnt = 0u; mine = 0u;
#pragma unroll
        for (unsigned j = 0; j < 16; ++j) { const unsigned c = xb_ld(&bar[XB_XCNT(j)]); sum += c; cnt += (c > 0u) ? 1u : 0u; mine = (j == x) ? c : mine; }
        if (sum == G) break;
        __builtin_amdgcn_s_sleep(1);
        if ((++sp & 255u) == 0u) { if (xb_ld(&bar[XB_TMO])) break; if (sp > XB_SPIN_CAP) { atomicAdd(&bar[XB_TMO], 1u); break; } }
    }
    nloc = mine > 0u ? mine : 1u; nx = cnt > 0u ? cnt : 1u;
}

__device__ __forceinline__ void xcd_barrier(const XcdBarrier& b) {
    asm volatile("s_waitcnt vmcnt(0)" ::: "memory");
    __syncthreads();
    if (threadIdx.x == 0) {
        unsigned* bar = b.bar;
        __builtin_amdgcn_s_waitcnt(0);
        unsigned nloc = b.st[0], nx = b.st[1];
        if (nloc == 0u) { xcd_barrier_complete(bar, b.x, nloc, nx); b.st[0] = nloc; b.st[1] = nx; }
        const unsigned old = xb_add(&bar[XB_XSUB(b.x)], 1u);
        const unsigned gen = old / nloc;
        if (old + 1u == (gen + 1u) * nloc) {
            __builtin_amdgcn_fence(__ATOMIC_RELEASE, "agent");
            asm volatile("s_waitcnt vmcnt(0)" ::: "memory");
            const unsigned og = xb_add(&bar[XB_TOP], 1u);
            const unsigned tg = og / nx;
            if (og + 1u == (tg + 1u) * nx) xb_add(&bar[XB_TOPGEN], 1u);
            else XB_SPIN(xb_ld(&bar[XB_TOPGEN]) == tg, bar);
            __builtin_amdgcn_fence(__ATOMIC_ACQUIRE, "agent");
            xb_add(&bar[XB_XGEN(b.x)], 1u);
            asm volatile("s_waitcnt vmcnt(0)" ::: "memory");
        } else {
            XB_SPIN(xb_ld(&bar[XB_XGEN(b.x)]) == gen, bar);
            __builtin_amdgcn_fence(__ATOMIC_ACQUIRE, "agent");
            asm volatile("s_waitcnt vmcnt(0)" ::: "memory");
        }
    }
    __syncthreads();
}

#ifndef IN_NT
#define IN_NT 0
#endif
#if IN_NT
#define IN_LOAD(p) __builtin_nontemporal_load(p)
#else
#define IN_LOAD(p) (*(p))
#endif
template <int MODE> __device__ __forceinline__ int rowmap(int n, int row_off) {
    if (MODE == 1) return ((n >> 7) << 8) + (n & 127) + row_off;
    if (MODE == 2) { const int h = n / 192; int d = n - h * 192; if (d >= 128) { const int t = d - 128, a = t >> 5, p = (t >> 4) & 1, i = t & 15; d = 128 + a * 32 + 2 * i + p; } return h * 192 + d; }
    if (MODE == 3) return n < 768 ? n : (n < 832 ? 3328 + (n - 768) : n - 64);
    return n + row_off;
}
constexpr int WCOPY_NALL = 8 * 32 * 176 + 4 * 88 * 64 + 2 * (32 * 106 + 8 * 48 + 4 * 64 + 32 * 64), WCOPY_NTAIL = 2 * 32 * 176 + 88 * 64, WCOPY_NPRO = WCOPY_NALL - 2 * WCOPY_NTAIL;
template <int SET> __device__ __forceinline__ void wcopy_set(LAS unsigned char* lds, int lf_tail, int v0, int vcnt, int wg, int nwg) {
    const int tid = opaque_tid(), lane = tid & 63, wave = __builtin_amdgcn_readfirstlane(tid >> 6);
    {
        LAS float* scr = (LAS float*)(lds + wave * 8704);
        const int gw = wg * 8 + wave, NGW = nwg * 8;
        constexpr int I_GU = 32 * 176, I_D = 88 * 64, I_IN = 32 * 106, I_QB = 8 * 48, I_KVB = 4 * 64, I_OUT = 32 * 64;
        constexpr int NALL = 8 * I_GU + 4 * I_D + 2 * (I_IN + I_QB + I_KVB + I_OUT), NTAIL = 2 * I_GU + I_D, NITEMS = SET == 0 ? NALL - 2 * NTAIL : NTAIL;
        auto vmap = [&](int v) { if (SET == 0) return v < 2 * I_GU ? v : (v < 4 * I_GU ? v + 2 * I_GU : (v < 4 * I_GU + I_D ? v + 4 * I_GU : (v < 4 * I_GU + 2 * I_D ? v + 4 * I_GU + I_D : v + 4 * I_GU + 2 * I_D)));
                                 return v < 2 * I_GU ? 2 * lf_tail * I_GU + v : 8 * I_GU + lf_tail * I_D + (v - 2 * I_GU); };
        struct Item { const float* src; bf16* dst; int N, trows, mode, row_off, kb, n0; float scale; };
        auto decode = [&](int it, Item& d) {
            int r = it; const float* W; int K, N, item; d.scale = 1.0f;
            if (r < 8 * I_GU) { const int mat = r / I_GU, lf = mat >> 1, up = mat & 1; item = r - mat * I_GU;
                W = INP(up ? I_WU : I_WG) + (size_t)lf * DM * FF; K = DM; N = FF; d.dst = WSP(bf16, WS_WGU) + (size_t)lf * 2 * FF * DM; d.trows = 2 * FF; d.mode = 1; d.row_off = up * 128; d.scale = up ? -0.6931471805599453f : -1.4426950408889634f; }
            else if ((r -= 8 * I_GU) < 4 * I_D) { const int lf = r / I_D; item = r - lf * I_D;
                W = INP(I_WD) + (size_t)lf * FF * DM; K = FF; N = DM; d.dst = WSP(bf16, WS_WD) + (size_t)lf * DM * FF; d.trows = DM; d.mode = 0; d.row_off = 0; }
            else if ((r -= 4 * I_D) < 2 * I_IN) { const int l = r / I_IN; item = r - l * I_IN;
                W = INP(I_WIN) + (size_t)l * DM * NIN; K = DM; N = NIN; d.dst = WSP(bf16, WS_WIN) + (size_t)l * NINP * DM; d.trows = NINP; d.mode = 3; d.row_off = 0; }
            else if ((r -= 2 * I_IN) < 2 * I_QB) { const int l = r / I_QB; item = r - l * I_QB;
                W = INP(I_WQB) + (size_t)l * 512 * NQ; K = 512; N = NQ; d.dst = WSP(bf16, WS_WQB) + (size_t)l * NQ * 512; d.trows = NQ; d.mode = 2; d.row_off = 0; }
            else if ((r -= 2 * I_QB) < 2 * I_KVB) { const int l = r / I_KVB; item = r - l * I_KVB;
                W = INP(I_WKVB) + (size_t)l * 256 * 2048; K = 256; N = 2048; d.dst = WSP(bf16, WS_WKVB) + (size_t)l * 2048 * 256; d.trows = 2048; d.mode = 0; d.row_off = 0; }
            else { r -= 2 * I_KVB; const int l = r / I_OUT; item = r - l * I_OUT;
                W = INP(I_WOUT) + (size_t)l * DM * DM; K = DM; N = DM; d.dst = WSP(bf16, WS_WOUT) + (size_t)l * DM * DM; d.trows = DM; d.mode = 0; d.row_off = 0; }
            (void)K; const int nblk = N / 32; d.kb = item / nblk; d.n0 = 32 * (item - d.kb * nblk); d.N = N; d.src = W + (size_t)(64 * d.kb) * N + d.n0;
        };
        auto load = [&](const Item& d, float (&v)[32]) {
            const float* s = d.src + (size_t)(lane >> 5) * d.N + (lane & 31);
#pragma unroll
            for (int i = 0; i < 32; ++i) v[i] = IN_LOAD(s + (size_t)(2 * i) * d.N);
        };
        Item cur, nxt; float vc[32], vn[32];
        const int vend = v0 + vcnt;
        if (v0 + gw < vend) { decode(vmap(v0 + gw), cur); load(cur, vc); }
        for (int it = v0 + gw; it < vend; it += NGW) {
            const bool more = it + NGW < vend;
            if (more) { decode(vmap(it + NGW), nxt); load(nxt, vn); }
#pragma unroll
            for (int i = 0; i < 32; ++i) scr[(2 * i + (lane >> 5)) * 33 + (lane & 31)] = vc[i];
            asm volatile("s_waitcnt lgkmcnt(0)" ::: "memory");
            const int c = lane & 7;
#pragma unroll
            for (int j = 0; j < 4; ++j) { const int n = (lane >> 3) + 8 * j; const LAS float* s = scr + (8 * c) * 33 + n;
                const float sc = cur.scale;
                v4u o; o.x = pk2(s[0 * 33] * sc, s[1 * 33] * sc); o.y = pk2(s[2 * 33] * sc, s[3 * 33] * sc); o.z = pk2(s[4 * 33] * sc, s[5 * 33] * sc); o.w = pk2(s[6 * 33] * sc, s[7 * 33] * sc);
                const int nn = cur.n0 + n;
                const int drow = cur.mode == 1 ? rowmap<1>(nn, cur.row_off) : (cur.mode == 2 ? rowmap<2>(nn, 0) : (cur.mode == 3 ? rowmap<3>(nn, 0) : nn));
                *(GAS v4u*)(cur.dst + ((size_t)cur.kb * cur.trows + drow) * 64 + 8 * c) = o; }
            asm volatile("s_waitcnt lgkmcnt(0)" ::: "memory");
            if (more) { cur = nxt;
#pragma unroll
                for (int i = 0; i < 32; ++i) vc[i] = vn[i]; }
        }
    }
}
__device__ __forceinline__ void prologue_phase(const Args& A, LAS unsigned char* lds) {
    const int tid = opaque_tid(), lane = tid & 63, wave = __builtin_amdgcn_readfirstlane(tid >> 6), G = gridDim.x;
    {
        LAS float* sil = (LAS float*)lds;
        float* mods = WSP(float, WS_MODS);
        const float* cin = INP(I_C); const float* cctx = INP(I_CCTX); const float* aw = INP(I_ADAW); const float* ab = INP(I_ADAB);
        for (int it = blockIdx.x; it < 256; it += G) {
            for (int e = tid; e < 9 * 2048; e += 512) { const int cb = e >> 11, k = e & 2047; const float c = cb < 8 ? cin[cb * 2048 + k] : cctx[k]; sil[e] = silu_f(c); }
            __syncthreads();
            const int l = it >> 7, n0 = (it & 127) * 144, cg = tid % 36, ks = tid / 36;
            f32x4 acc[9];
#pragma unroll
            for (int cb = 0; cb < 9; ++cb) acc[cb] = (f32x4){0.f, 0.f, 0.f, 0.f};
            if (ks < 14) {
                const int klo = ks * 147, khi = (klo + 147) < 2048 ? (klo + 147) : 2048;
                const float* wp = aw + ((size_t)l * 2048 + klo) * NMOD + n0 + cg * 4;
#pragma unroll 7
                for (int k = klo; k < khi; ++k) { const f32x4 w = IN_LOAD((const f32x4*)wp); wp += NMOD;
#pragma unroll
                    for (int cb = 0; cb < 9; ++cb) acc[cb] += sil[cb * 2048 + k] * w; }
            }
            __syncthreads();
            if (ks < 14) {
#pragma unroll
                for (int cb = 0; cb < 9; ++cb) *(LAS f32x4*)(sil + (ks * 9 + cb) * 144 + cg * 4) = acc[cb];
            }
            __syncthreads();
            for (int o = tid; o < 9 * 144; o += 512) { const int cb = o / 144, n = o - cb * 144; float s = ab[l * NMOD + n0 + n];
#pragma unroll
                for (int k2 = 0; k2 < 14; ++k2) s += sil[(k2 * 9 + cb) * 144 + n];
                mods[((size_t)l * 9 + cb) * NMOD + n0 + n] = s; }
            __syncthreads();
        }
    }
    if (blockIdx.x == 0) {
        f32x2* r64 = WSP(f32x2, WS_ROPE); f32x2* r128 = r64 + 64 * 16;
        for (int e = tid; e < 64 * 16 + 64 * 32; e += 512) {
            int pos, i, q; if (e < 1024) { pos = e >> 4; i = e & 15; q = 16; } else { const int f = e - 1024; pos = f >> 5; i = f & 31; q = 32; }
            const float inv = __builtin_amdgcn_exp2f(-13.287712379549449f * (float)i / (float)q);
            const float rev = (float)pos * inv * 0.15915494309189535f; const float fr = rev - __builtin_rintf(rev);
            const f32x2 v = {__builtin_amdgcn_cosf(fr), __builtin_amdgcn_sinf(fr)};
            if (e < 1024) r64[e] = v; else r128[e - 1024] = v;
        }
    }
    for (int e = blockIdx.x * 512 + tid; e < 2 * 32 * 192 * 8; e += G * 512) { const int ls = e / (192 * 8), r = e - ls * 192 * 8;
        *(v4u*)(WSP(bf16, WS_WIN) + ((size_t)ls * NINP + NIN) * 64 + (size_t)r * 8) = (v4u){0u, 0u, 0u, 0u}; }
    wcopy_set<0>(lds, 0, 0, WCOPY_NPRO, blockIdx.x, G);
}

template <bool FIRST> __device__ __forceinline__ void norm_phase(const float* xA, const float* xB, int l, int k) {
    const int tid = opaque_tid(), lane = tid & 63, wave = tid >> 6;
    const float* mods = WSP(float, WS_MODS); bf16* H = WSP(bf16, WS_H); bf16* X = WSP(bf16, WS_X);
    const f32x4* g4 = (const f32x4*)(INP(I_NORMG) + (size_t)(l * 3 + k) * DM);
    typedef typename std::conditional<FIRST, f32x4, v2u>::type RawT;
    auto load_row = [&](int row, RawT (&r)[8]) {
        if constexpr (FIRST) { const f32x4* xr = (const f32x4*)((row < NCTX ? xA : xB) + (size_t)row * DM);
#pragma unroll
            for (int j = 0; j < 8; ++j) r[j] = xr[lane + 64 * j];
        } else { const v2u* xr = (const v2u*)(X + (size_t)row * DM);
#pragma unroll
            for (int j = 0; j < 8; ++j) r[j] = xr[lane + 64 * j]; }
    };
    for (int chunk = blockIdx.x * 8 + wave; chunk < NTOK / 8; chunk += gridDim.x * 8) {
        const int r0 = chunk * 8, cb = r0 < NCTX ? 8 : ((r0 - NCTX) >> 10);
        const f32x4* sh4 = (const f32x4*)(mods + ((size_t)l * 9 + cb) * NMOD + (size_t)(3 * k) * DM); const f32x4* sc4 = sh4 + DM / 4;
        RawT cur[8], nxt[8];
        load_row(r0, cur);
        f32x4 ga[8], sh[8];
#pragma unroll
        for (int j = 0; j < 8; ++j) { const int c = lane + 64 * j; ga[j] = g4[c] * (1.0f + sc4[c]); sh[j] = sh4[c]; }
#pragma unroll 1
        for (int i = 0; i < 8; ++i) { const int row = r0 + i;
            if (i < 7) load_row(row + 1, nxt);
            f32x4 v[8]; float ss = 0.f;
#pragma unroll
            for (int j = 0; j < 8; ++j) { if constexpr (FIRST) v[j] = cur[j]; else v[j] = b4f(cur[j]); ss += dot4(v[j]); }
            if constexpr (FIRST) { v2u* x8 = (v2u*)(X + (size_t)row * DM);
#pragma unroll
                for (int j = 0; j < 8; ++j) x8[lane + 64 * j] = pk4(v[j]); }
            const float rstd = 1.0f / sqrtf(wave_sum(ss) * (1.0f / DM) + EPS);
#pragma unroll
            for (int j = 0; j < 8; ++j) { const int c = lane + 64 * j; *(v2u*)(H + ((size_t)(c >> 4) * NTOK + row) * 64 + 4 * (c & 15)) = pk4((v[j] * rstd) * ga[j] + sh[j]); }
#pragma unroll
            for (int j = 0; j < 8; ++j) cur[j] = nxt[j];
        }
    }
}
__device__ __forceinline__ void final_phase(const Args& A) {
    const int tid = opaque_tid(), lane = tid & 63, wave = tid >> 6;
    const bf16* X = WSP(bf16, WS_X); const f32x4* g4 = (const f32x4*)INP(I_FNORM);
    const int row0 = blockIdx.x * 8 + wave, rstep = gridDim.x * 8;
    f32x4 gf[8];
#pragma unroll
    for (int j = 0; j < 8; ++j) gf[j] = g4[lane + 64 * j];
    v2u cur[8], nxt[8];
    if (row0 < NTOK) { const v2u* xr = (const v2u*)(X + (size_t)row0 * DM);
#pragma unroll
        for (int j = 0; j < 8; ++j) cur[j] = xr[lane + 64 * j]; }
    for (int row = row0; row < NTOK; row += rstep) {
        if (row + rstep < NTOK) { const v2u* xr = (const v2u*)(X + (size_t)(row + rstep) * DM);
#pragma unroll
            for (int j = 0; j < 8; ++j) nxt[j] = xr[lane + 64 * j]; }
        f32x4 v[8]; float ss = 0.f;
#pragma unroll
        for (int j = 0; j < 8; ++j) { v[j] = b4f(cur[j]); ss += dot4(v[j]); }
        const float rstd = 1.0f / sqrtf(wave_sum(ss) * (1.0f / DM) + EPS);
        f32x4* o = (f32x4*)(OUTP() + O_Y + (size_t)row * DM);
#pragma unroll
        for (int j = 0; j < 8; ++j) { const int c = lane + 64 * j; OUT_STORE(o + c, (v[j] * rstd) * gf[j]); }
#pragma unroll
        for (int j = 0; j < 8; ++j) cur[j] = nxt[j];
    }
}

__device__ __forceinline__ void post_phase(const Args& A, int l) {
    const int tid = opaque_tid(), lane = tid & 63, wave = tid >> 6, gw = blockIdx.x * 8 + wave, NGW = gridDim.x * 8;
    const bf16* MIX = WSP(bf16, WS_ACT);
    const f32x2* r64 = WSP(f32x2, WS_ROPE); const f32x2* r128 = r64 + 64 * 16;
    bf16 *CQN = WSP(bf16, WS_CQN), *CKVN = WSP(bf16, WS_CKVN), *KRC = WSP(bf16, WS_KRC), *KRL = WSP(bf16, WS_KRL), *NAQ = WSP(bf16, WS_NAQ), *NAKC = WSP(bf16, WS_NAKC), *NAVC = WSP(bf16, WS_NAVC),
         *NAKL = WSP(bf16, WS_NAKL), *NAVL = WSP(bf16, WS_NAVL), *GQ = WSP(bf16, WS_GQ), *GKC = WSP(bf16, WS_GKC), *GVC = WSP(bf16, WS_GVC), *GKL = WSP(bf16, WS_GKL), *GVL = WSP(bf16, WS_GVL);
    float* out = OUTP();
    const float* qn = INP(I_QNORM) + l * 512; const float* kvn = INP(I_KVNORM) + l * 256; const float* gqn = INP(I_GQN) + l * 128; const float* gkn = INP(I_GKN) + l * 128;
    const int hh = lane >> 5, i32 = lane & 31;
    const f32x4 qn0 = *(const f32x4*)(qn + lane * 4), qn1 = *(const f32x4*)(qn + 256 + lane * 4), kvn4 = *(const f32x4*)(kvn + lane * 4);
    float gq4[4], gk4[4];
#pragma unroll
    for (int q = 0; q < 4; ++q) { gq4[q] = gqn[q * 32 + i32]; gk4[q] = gkn[q * 32 + i32]; }
    struct RowIn { v2u q0, q1, kv; bf16 kr1, kr2, gq[2][4], gk[4]; f32x2 c64, c0, c1; };
    auto load_row = [&](int row, RowIn& R) {
        const bf16* mr = MIX + (size_t)row * NINP;
        R.q0 = *(const v2u*)(mr + lane * 4); R.q1 = *(const v2u*)(mr + 256 + lane * 4); R.kv = *(const v2u*)(mr + 512 + lane * 4);
        const int a = (lane >> 4) & 1, i = lane & 15; R.kr1 = mr[3328 + a * 32 + i]; R.kr2 = mr[3328 + a * 32 + 16 + i];
#pragma unroll
        for (int pp = 0; pp < 2; ++pp)
#pragma unroll
            for (int q = 0; q < 4; ++q) R.gq[pp][q] = mr[2304 + (2 * pp + hh) * 128 + q * 32 + i32];
#pragma unroll
        for (int q = 0; q < 4; ++q) R.gk[q] = mr[2816 + hh * 128 + q * 32 + i32];
        if (row >= NCTX) { const int t = (row - NCTX) & 1023; R.c64 = r64[(a ? (t & 63) : (t >> 6)) * 16 + i]; R.c0 = r128[(t >> 6) * 32 + i32]; R.c1 = r128[(t & 63) * 32 + i32]; }
    };
    auto b2f = [](bf16 v) { return __builtin_bit_cast(float, (unsigned)v << 16); };
    for (int chunk = gw; chunk < NTOK / 8; chunk += NGW) {
        RowIn cur, nxt;
        load_row(chunk * 8, cur);
#pragma unroll 1
        for (int ri = 0; ri < 8; ++ri) { const int row = chunk * 8 + ri;
        if (ri < 7) load_row(row + 1, nxt);
        const bool ctx = row < NCTX;
        int b, t; size_t lrow = 0, orow = 0;
        if (ctx) { b = row >> 8; t = row & 255; orow = (size_t)(b * 2 + l) * 256 + t; } else { const int r2 = row - NCTX; b = r2 >> 10; t = r2 & 1023; lrow = (size_t)b * 1536 + 512 + t; }
        { const f32x4 q0 = b4f(cur.q0), q1 = b4f(cur.q1);
          const float rstd = 1.0f / sqrtf(wave_sum(dot4(q0) + dot4(q1)) * (1.0f / 512.0f) + EPS);
          *(v2u*)(CQN + ((size_t)(lane >> 4) * NTOK + row) * 64 + 4 * (lane & 15)) = pk4(q0 * rstd * qn0);
          *(v2u*)(CQN + ((size_t)(4 + (lane >> 4)) * NTOK + row) * 64 + 4 * (lane & 15)) = pk4(q1 * rstd * qn1); }
        { const f32x4 kv = b4f(cur.kv);
          const float rstd = 1.0f / sqrtf(wave_sum(dot4(kv)) * (1.0f / 256.0f) + EPS);
          const f32x4 y = kv * rstd * kvn4;
          if (ctx) OUT_STORE((f32x4*)(out + O_CKV + orow * 256 + lane * 4), y);
          *(v2u*)(CKVN + ((size_t)(lane >> 4) * NKVROWS + row) * 64 + 4 * (lane & 15)) = pk4(y); }
        if (lane < 32) { const int a = lane >> 4, i = lane & 15; const float x1 = b2f(cur.kr1), x2 = b2f(cur.kr2);
          if (ctx) { out[O_KR + orow * 64 + a * 32 + i] = x1; out[O_KR + orow * 64 + a * 32 + 16 + i] = x2; *(unsigned*)(KRC + (size_t)row * 64 + a * 32 + 2 * i) = pk2(x1, x2); }
          else { const f32x2 cs = cur.c64; *(unsigned*)(KRL + lrow * 64 + a * 32 + 2 * i) = pk2(x1 * cs.x - x2 * cs.y, x2 * cs.x + x1 * cs.y); } }
#pragma unroll
        for (int pp = 0; pp < 2; ++pp) { const int head = 2 * pp + hh; float x[4];
#pragma unroll
          for (int q = 0; q < 4; ++q) x[q] = b2f(cur.gq[pp][q]);
          const float rstd = 1.0f / sqrtf(half_sum((x[0] * x[0] + x[1] * x[1]) + (x[2] * x[2] + x[3] * x[3])) * (1.0f / 128.0f) + EPS);
#pragma unroll
          for (int q = 0; q < 4; ++q) x[q] = x[q] * rstd * gq4[q];
          if (!ctx) { const f32x2 c0 = cur.c0, c1 = cur.c1;
            const float y0 = x[0] * c0.x - x[1] * c0.y, y1 = x[1] * c0.x + x[0] * c0.y, y2 = x[2] * c1.x - x[3] * c1.y, y3 = x[3] * c1.x + x[2] * c1.y; x[0] = y0; x[1] = y1; x[2] = y2; x[3] = y3; }
#pragma unroll
          for (int q = 0; q < 4; ++q) GQ[(size_t)row * 512 + head * 128 + q * 32 + i32] = f2bf(x[q]); }
        { float x[4];
#pragma unroll
          for (int q = 0; q < 4; ++q) x[q] = b2f(cur.gk[q]);
          const float rstd = 1.0f / sqrtf(half_sum((x[0] * x[0] + x[1] * x[1]) + (x[2] * x[2] + x[3] * x[3])) * (1.0f / 128.0f) + EPS);
#pragma unroll
          for (int q = 0; q < 4; ++q) x[q] = x[q] * rstd * gk4[q];
          if (ctx) {
#pragma unroll
            for (int q = 0; q < 4; ++q) { out[O_GK + orow * 256 + hh * 128 + q * 32 + i32] = x[q]; GKC[(size_t)row * 256 + hh * 128 + q * 32 + i32] = f2bf(x[q]); }
          } else { const f32x2 c0 = cur.c0, c1 = cur.c1;
            const float y0 = x[0] * c0.x - x[1] * c0.y, y1 = x[1] * c0.x + x[0] * c0.y, y2 = x[2] * c1.x - x[3] * c1.y, y3 = x[3] * c1.x + x[2] * c1.y;
            bf16* d = GKL + lrow * 256 + hh * 128 + i32; d[0] = f2bf(y0); d[32] = f2bf(y1); d[64] = f2bf(y2); d[96] = f2bf(y3); } }
        cur = nxt;
        }
    }
    for (int r = gw; r < 4096; r += NGW) { const int b = r >> 9, pp = r & 511; const size_t src = (size_t)(b * 2 + l) * 512 + pp, lrow = (size_t)b * 1536 + pp;
        const int a = (lane >> 4) & 1, i = lane & 15; const float* s = INP(I_CKR) + src * 64;
        const f32x4 ckv = *(const f32x4*)(INP(I_CCKV) + src * 256 + lane * 4); const float k1 = s[a * 32 + i], k2 = s[a * 32 + 16 + i];
        const f32x4 nk0 = *(const f32x4*)(INP(I_CNAK) + src * 512 + lane * 4), nk1 = *(const f32x4*)(INP(I_CNAK) + src * 512 + 256 + lane * 4);
        const f32x4 nv0 = *(const f32x4*)(INP(I_CNAV) + src * 512 + lane * 4), nv1 = *(const f32x4*)(INP(I_CNAV) + src * 512 + 256 + lane * 4);
        const f32x4 gk = *(const f32x4*)(INP(I_CGK) + src * 256 + lane * 4), gv = *(const f32x4*)(INP(I_CGV) + src * 256 + lane * 4);
        *(v2u*)(CKVN + ((size_t)(lane >> 4) * NKVROWS + NTOK + r) * 64 + 4 * (lane & 15)) = pk4(ckv);
        if (lane < 32) *(unsigned*)(KRL + lrow * 64 + a * 32 + 2 * i) = pk2(k1, k2);
        *(v2u*)(NAKL + lrow * 512 + lane * 4) = pk4(nk0); *(v2u*)(NAKL + lrow * 512 + 256 + lane * 4) = pk4(nk1);
        *(v2u*)(NAVL + lrow * 512 + lane * 4) = pk4(nv0); *(v2u*)(NAVL + lrow * 512 + 256 + lane * 4) = pk4(nv1);
        *(v2u*)(GKL + lrow * 256 + lane * 4) = pk4(gk); *(v2u*)(GVL + lrow * 256 + lane * 4) = pk4(gv);
    }
}

#ifndef ATT_SD192
#define ATT_SD192 1
#endif
#ifndef ATT_SD128
#define ATT_SD128 1
#endif
#ifndef ATT_SDH
#define ATT_SDH 1
#endif
template <class F> __device__ __forceinline__ void queue_loop(char* lds, unsigned* qhead, int n, F&& unit) {
    volatile int* bc = (volatile int*)(lds + att::OFF_BC);
    for (;;) {
        if (opaque_tid() == 0) *bc = (int)__hip_atomic_fetch_add(qhead, 1u, __ATOMIC_RELAXED, __HIP_MEMORY_SCOPE_AGENT);
        __syncthreads();
        const int idx = __builtin_amdgcn_readfirstlane(*bc);
        if (idx >= n) break;
        unit(idx);
    }
    __syncthreads();
}
__device__ __forceinline__ void attn_phase(const Args& A, int l, char* lds, unsigned* qh) {
    queue_loop(lds, qh, 128, [&](int i) {
        const int tid = opaque_tid(), b = i >> 4, h = (i >> 2) & 3, qt = i & 3; const size_t qrow = (size_t)NCTX + b * 1024 + qt * 256, kr0 = (size_t)b * 1536;
        const int lo = qt == 2 ? 4 : (qt == 3 ? 8 : 0), nloc = (qt == 0 || qt == 3) ? 8 : 12;
        float* T = (float*)(lds + att::OFF_T); const float* rpb = INP(I_RPB) + (size_t)(l * 4 + h) * 15 * 31;
        for (int e = tid; e < 15 * 128; e += 512) { const int dr = e >> 7, dc = (e & 127) - 48; T[e] = (dc >= 0 && dc < 31) ? rpb[dr * 31 + dc] * 11.313708498984761f : 0.f; }
        if (tid < 128) ((float*)(lds + att::OFF_PEN))[tid] = (tid >= 63 && tid < 79) ? 0.f : -1e30f;
        __syncthreads();
        att::attn_unit<128, true, ATT_SDH, 4>(WSP(bf16, WS_NAQ) + qrow * 512 + h * 128, 512, WSP(bf16, WS_NAKL) + kr0 * 512 + h * 128, 512, nullptr, WSP(bf16, WS_NAVL) + kr0 * 512 + h * 128,
                                              WSP(bf16, WS_O), (int)qrow, 1024 + h * 128, 8 + nloc, 8, 512 + 64 * lo, 4 * qt, lo, lds); });
    queue_loop(lds, qh + 64, 128, [&](int i) {
        const int b = i >> 4, h = (i >> 2) & 3, qt = i & 3; const size_t qrow = (size_t)NCTX + b * 1024 + qt * 256, kr0 = (size_t)b * 1536;
        att::attn_unit<128, false, ATT_SD128, 8>(WSP(bf16, WS_GQ) + qrow * 512 + h * 128, 512, WSP(bf16, WS_GKL) + kr0 * 256 + (h >> 1) * 128, 256, nullptr, WSP(bf16, WS_GVL) + kr0 * 256 + (h >> 1) * 128,
                                                 WSP(bf16, WS_O), (int)qrow, 1536 + h * 128, 24, 24, 0, 0, 0, lds); });
    queue_loop(lds, qh + 128, 512, [&](int idx) {
        const bf16 *Qp, *Kp, *Rp, *Vp; int orow, ocol, NT;
        if (idx < 256) { const int b = idx >> 5, h = (idx >> 2) & 7, qt = idx & 3; const size_t qrow = (size_t)NCTX + b * 1024 + qt * 256, kr0 = (size_t)b * 1536;
            Qp = WSP(bf16, WS_QMLA) + qrow * NQ + h * 192; Kp = WSP(bf16, WS_KNL) + kr0 * 1024 + h * 128; Rp = WSP(bf16, WS_KRL) + kr0 * 64; Vp = WSP(bf16, WS_VML) + kr0 * 1024 + h * 128; orow = (int)qrow; ocol = h * 128; NT = 24; }
        else { const int i = idx - 256, b = i >> 3, h = i & 7; const size_t r0 = (size_t)b * 256;
            Qp = WSP(bf16, WS_QMLA) + r0 * NQ + h * 192; Kp = WSP(bf16, WS_KNC) + r0 * 1024 + h * 128; Rp = WSP(bf16, WS_KRC) + r0 * 64; Vp = WSP(bf16, WS_VMC) + r0 * 1024 + h * 128; orow = (int)r0; ocol = h * 128; NT = 4; }
        att::attn_unit<192, false, ATT_SD192, 8>(Qp, NQ, Kp, 1024, Rp, Vp, WSP(bf16, WS_O), orow, ocol, NT, NT, 0, 0, 0, lds); });
    queue_loop(lds, qh + 192, 256, [&](int idx) {
        const int i = idx & 127, b = i >> 2, h = i & 3; const size_t r0 = (size_t)b * 256;
        const bf16 *Qp, *Kp, *Vp; int ocol, ldk;
        if (idx < 128) { Qp = WSP(bf16, WS_NAQ) + r0 * 512 + h * 128; Kp = WSP(bf16, WS_NAKC) + r0 * 512 + h * 128; Vp = WSP(bf16, WS_NAVC) + r0 * 512 + h * 128; ocol = 1024 + h * 128; ldk = 512; }
        else { Qp = WSP(bf16, WS_GQ) + r0 * 512 + h * 128; Kp = WSP(bf16, WS_GKC) + r0 * 256 + (h >> 1) * 128; Vp = WSP(bf16, WS_GVC) + r0 * 256 + (h >> 1) * 128; ocol = 1536 + h * 128; ldk = 256; }
        att::attn_unit<128, false, ATT_SD128, 8>(Qp, 512, Kp, ldk, nullptr, Vp, WSP(bf16, WS_O), (int)r0, ocol, 4, 4, 0, 0, 0, lds); });
}

#ifndef REP_PRO
#define REP_PRO 1
#endif
#ifndef REP_NORM
#define REP_NORM 1
#endif
#ifndef REP_GU
#define REP_GU 1
#endif
#ifndef REP_WIN
#define REP_WIN 1
#endif
#ifndef REP_POST
#define REP_POST 1
#endif
#ifndef REP_QKV
#define REP_QKV 1
#endif
#ifndef REP_DOWN
#define REP_DOWN 1
#endif
#ifndef REP_WOUT
#define REP_WOUT 1
#endif
#ifndef REP_ATT
#define REP_ATT 1
#endif
#ifndef MIXM
#define MIXM true
#endif
#ifndef GP_ALIGN
#define GP_ALIGN true
#endif
#ifndef GP_SP2
#define GP_SP2 true
#endif
#define REPEAT(n) _Pragma("unroll 1") for (int rep_ = 0; rep_ < (n); ++rep_)
constexpr int NPH = 26;
__global__ void __launch_bounds__(512, 2) hybrid_fwd(Args A) {
    extern __shared__ __attribute__((aligned(16))) unsigned char lds[];
    LAS unsigned char* ldsl = (LAS unsigned char*)lds;
    const int tid = threadIdx.x;
    volatile LAS unsigned* misc = (volatile LAS unsigned*)(ldsl + LDS_MISC);
    if (tid < 8) misc[tid] = 0u;
    __syncthreads();
    const int lo = A.ph_lo, hi = A.ph_hi;
    XcdBarrier bar; bar.bar = nullptr; bar.x = 0; bar.st = misc;
    if (hi - lo > 1) bar = xcd_barrier_post(WSP(unsigned, WS_CTL) + CW_BAR, misc);
#define PH_BEGIN if (ph >= lo && ph < hi) {
#define PH_END   if (ph + 1 < hi) { XcdBarrier b2_ = bar; b2_.bar = WSP(unsigned, WS_CTL) + CW_BAR; asm volatile("" : "+s"(b2_.x)); xcd_barrier(b2_); } } ++ph;
    int ph = 0;
    const int G = gridDim.x;
#define bx opaque_bx()

    PH_BEGIN REPEAT(REP_PRO) { prologue_phase(A, ldsl); __syncthreads(); } PH_END

#pragma unroll 1
    for (int l = 0; l < 2; ++l) {
#pragma unroll 1
        for (int sub = 0; sub < 2; ++sub) {
            const bool first = (l == 0 && sub == 0);
            const int k = sub ? 2 : 0, lf = l * 2 + sub;
            PH_BEGIN REPEAT(REP_NORM) { if (first) norm_phase<true>(INP(I_XP), INP(I_XS) - (size_t)NCTX * DM, l, k); else norm_phase<false>(nullptr, nullptr, l, k); } PH_END
            PH_BEGIN REPEAT(REP_GU) {
                pg8::Gemm g = pg8::Gemm::make(WSP(bf16, WS_H), true, 0, WSP(bf16, WS_WGU) + (size_t)lf * 2 * FF * DM, true, 0, NTOK, 2 * FF, DM); pg8::StaticOrder S; S.init(NTOK, 2 * FF, G, bx);
                EpiSwiglu E{WSP(bf16, WS_ACT)};
                pg8::gemm_phase<EpiSwiglu, pg8::StaticOrder, GP_ALIGN, GP_SP2>(ldsl, g, S, E);
            } PH_END
            PH_BEGIN REPEAT(REP_DOWN) {
                pg8::Gemm g = pg8::Gemm::make(WSP(bf16, WS_ACT), true, 0, WSP(bf16, WS_WD) + (size_t)lf * DM * FF, true, 0, NTOK, DM, FF);
                pg8::StaticOrder S; S.init(NTOK, DM, G, bx);
                bf16* X = WSP(bf16, WS_X); bf16* Xo = rep_ ? WSP(bf16, WS_CQN) : X;   EpiResid E{X, Xo, WSP(float, WS_MODS) + (size_t)l * 9 * NMOD + (size_t)(3 * k + 2) * DM, 0.5f};
                pg8::gemm_phase<EpiResid, pg8::StaticOrder, GP_ALIGN, GP_SP2>(ldsl, g, S, E);
            } PH_END
            if (sub == 0) {
                PH_BEGIN REPEAT(REP_NORM) { norm_phase<false>(nullptr, nullptr, l, 1); } PH_END
                PH_BEGIN REPEAT(REP_WIN) {
                    pg8::Gemm g = pg8::Gemm::make(WSP(bf16, WS_H), true, 0, WSP(bf16, WS_WIN) + (size_t)l * NINP * DM, true, 0, NTOK, NINP, DM); pg8::StaticOrder S; S.init(NTOK, NINP, G, bx); S.mixm = MIXM && G == 256;
                    EpiMix E{WSP(bf16, WS_ACT), NINP, WSP(bf16, WS_NAQ), WSP(bf16, WS_NAKC), WSP(bf16, WS_NAVC), WSP(bf16, WS_NAKL), WSP(bf16, WS_NAVL), WSP(bf16, WS_GVC), WSP(bf16, WS_GVL),
                             OUTP() + O_NAK + (size_t)l * 256 * 512, OUTP() + O_NAV + (size_t)l * 256 * 512, OUTP() + O_GV + (size_t)l * 256 * 256};
                    pg8::gemm_phase<EpiMix, pg8::StaticOrder, GP_ALIGN, GP_SP2>(ldsl, g, S, E);
                    { const int rem = ((NTOK / 256) * (NINP / 256)) % G, c = bx; constexpr int NI = WCOPY_NTAIL - WCOPY_NTAIL / 11;
                      int v0 = 0, cnt = WCOPY_NTAIL, wg = c, nw = G;
                      if (rem) { if (c >= rem) { cnt = NI; wg = c - rem; nw = G - rem; } else { v0 = NI; cnt = WCOPY_NTAIL - NI; nw = rem; } }
                      wcopy_set<1>(ldsl, 2 * l + 1, v0, cnt, wg, nw); __syncthreads(); }
                } PH_END
                PH_BEGIN REPEAT(REP_POST) { post_phase(A, l); } PH_END
                PH_BEGIN REPEAT(REP_QKV) {
                    { pg8::Gemm g = pg8::Gemm::make(WSP(bf16, WS_CQN), true, 0, WSP(bf16, WS_WQB) + (size_t)l * NQ * 512, true, 0, NTOK, NQ, 512); pg8::StaticOrder S; S.init(NTOK, NQ, G, bx);
                      EpiQRope E{WSP(bf16, WS_QMLA), WSP(f32x2, WS_ROPE)};
                      pg8::gemm_phase<EpiQRope, pg8::StaticOrder, GP_ALIGN, GP_SP2>(ldsl, g, S, E); }
                    { pg8::Gemm g = pg8::Gemm::make(WSP(bf16, WS_CKVN), true, 0, WSP(bf16, WS_WKVB) + (size_t)l * 2048 * 256, true, 0, NKVROWS, 2048, 256); pg8::StaticOrder S; S.init(NKVROWS, 2048, G, G - 1 - bx);
                      EpiKV E{WSP(bf16, WS_KNC), WSP(bf16, WS_VMC), WSP(bf16, WS_KNL), WSP(bf16, WS_VML)};
                      pg8::gemm_phase<EpiKV, pg8::StaticOrder, GP_ALIGN, GP_SP2>(ldsl, g, S, E); }
                } PH_END
                PH_BEGIN REPEAT(REP_ATT) { attn_phase(A, l, (char*)lds, WSP(unsigned, WS_CTL) + (l ? CW_Q1 : CW_Q0) + 1024 * rep_); __syncthreads(); } PH_END
                PH_BEGIN REPEAT(REP_WOUT) {
                    pg8::Gemm g = pg8::Gemm::make(WSP(bf16, WS_O), true, 0, WSP(bf16, WS_WOUT) + (size_t)l * DM * DM, true, 0, NTOK, DM, DM); pg8::StaticOrder S; S.init(NTOK, DM, G, bx);
                    bf16* X = WSP(bf16, WS_X); bf16* Xo = rep_ ? WSP(bf16, WS_ACT) : X; EpiResid E{X, Xo, WSP(float, WS_MODS) + (size_t)l * 9 * NMOD + (size_t)5 * DM, 1.0f};
                    pg8::gemm_phase<EpiResid, pg8::StaticOrder, GP_ALIGN, GP_SP2>(ldsl, g, S, E);
                } PH_END
            }
        }
    }
    PH_BEGIN final_phase(A); PH_END
#undef PH_BEGIN
#undef PH_END
#undef bx
}

extern "C" void kernel_launch(void* const* d_in, const int* in_sizes, int n_in, void* d_out, int out_size, void* d_ws, size_t ws_size, hipStream_t stream) {
    static int grid = 0;
    if (grid == 0) {
        if (n_in != 26 || ws_size < WS_END) { fprintf(stderr, "kernel_launch: expected 26 inputs and >= %zu bytes of workspace, got %d inputs, %zu bytes; nothing launched\n", (size_t)WS_END, n_in, ws_size); grid = -1; return; }
        int dev = 0, cus = 0, per_cu = 0;
        if (hipGetDevice(&dev) != hipSuccess || hipDeviceGetAttribute(&cus, hipDeviceAttributeMultiprocessorCount, dev) != hipSuccess) { grid = -1; return; }
        if (hipFuncSetAttribute((const void*)hybrid_fwd, hipFuncAttributeMaxDynamicSharedMemorySize, LDS_BYTES) != hipSuccess) { fprintf(stderr, "kernel_launch: hipFuncSetAttribute failed\n"); grid = -1; return; }
        if (hipOccupancyMaxActiveBlocksPerMultiprocessor(&per_cu, (const void*)hybrid_fwd, 512, LDS_BYTES) != hipSuccess || per_cu < 1)
            fprintf(stderr, "kernel_launch: note: occupancy query reports %d workgroups per CU\n", per_cu);
        (void)hipGetLastError();
        grid = cus;
    }
    if (grid < 0) return;
    (void)hipMemsetAsync((char*)d_ws + WS_CTL, 0, CTL_ZERO_BYTES, stream);
    Args a{};
    for (int i = 0; i < 26; ++i) a.in[i] = (const float*)d_in[i];
    a.out = (float*)d_out; a.ws = (unsigned char*)d_ws;
#if MK_ONE_LAUNCH
    a.ph_lo = 0; a.ph_hi = NPH;
    hipLaunchKernelGGL(hybrid_fwd, dim3(grid), dim3(512), LDS_BYTES, stream, a);
#else
    for (int ph = 0; ph < NPH; ++ph) { a.ph_lo = ph; a.ph_hi = ph + 1; hipLaunchKernelGGL(hybrid_fwd, dim3(grid), dim3(512), LDS_BYTES, stream, a); }
#endif
    const hipError_t le = hipPeekAtLastError();
    if (le != hipSuccess) fprintf(stderr, "kernel_launch: launch failed: %s\n", hipGetErrorName(le));
}
```

```cpp
#include <hip/hip_runtime.h>
#include <cstdio>
#include <cstdint>
#include <type_traits>
#ifndef MK_ONE_LAUNCH
#define MK_ONE_LAUNCH 1
#endif
namespace pg8 {
#define PG8_LAS __attribute__((address_space(3)))
typedef unsigned short bf16_t;
typedef short bf16x8 __attribute__((ext_vector_type(8)));
typedef float f32x4 __attribute__((ext_vector_type(4)));
typedef unsigned u32x4 __attribute__((ext_vector_type(4)));
constexpr int BM = 256, BK = 64, HALF = 128, HTB = HALF * BK * 2  , STAGE_BYTES = 8 * HTB, NXCD = 8, WGM = 8;

__host__ __device__ __forceinline__ int lds_byte(int r, int c) { const int st = (r >> 4) * 2 + (c >> 5), rr = r & 15, cc = c & 31, ob = rr * 64 + cc * 2; return st * 1024 + (ob ^ (((ob >> 9) & 1) << 5)); }
__host__ __device__ __forceinline__ void stage_rc(int b, int& R, int& C) { const int st = b / 1024, sb = b % 1024, swz = sb ^ (((sb >> 9) & 1) << 5); R = (st >> 1) * 16 + swz / 64; C = (st & 1) * 32 + (swz % 64) / 2; }
__host__ __device__ __forceinline__ int perm32(int rho) { const int n = rho >> 4, i = rho & 15; return 8 * (i >> 2) + 4 * n + (i & 3); }

struct Unit { int pm, pn; };
struct Gemm {
    const bf16_t* A; const bf16_t* Bt; int M, N, K, lda, ldb; size_t kstepA, kstepB;
    __host__ __device__ static Gemm make(const bf16_t* A, bool tiledA, int lda, const bf16_t* Bt, bool tiledB, int ldb, int M, int N, int K) {
        Gemm g; g.A = A; g.Bt = Bt; g.M = M; g.N = N; g.K = K; g.lda = tiledA ? 64 : lda; g.ldb = tiledB ? 64 : ldb; g.kstepA = tiledA ? (size_t)M * 128 : 128; g.kstepB = tiledB ? (size_t)N * 128 : 128; return g; }
};

struct StaticOrder {
    int nM, nN, nwg, G, c; bool mixm = false;
    __host__ __device__ void init(int M, int N, int G_, int c_) { nM = M / BM; nN = N / BM; nwg = nM * nN; G = G_; c = c_; }
    __host__ __device__ bool next(int i, Unit& u) const {
        const long L = (long)i * G + c; if (L >= nwg) return false;
        int wgid = (int)L; { const int q = nwg / NXCD, r = nwg % NXCD, xcd = wgid % NXCD, off = wgid / NXCD; wgid = (xcd < r ? xcd * (q + 1) : r * (q + 1) + (xcd - r) * q) + off; }
        const int nig = WGM * nN, gid = wgid / nig, fm = gid * WGM, gsz = (nM - fm) < WGM ? (nM - fm) : WGM;
        u.pm = fm + ((wgid % nig) % gsz); u.pn = (wgid % nig) / gsz;
        if (mixm && (i & 1)) u.pm = (u.pm + (nM >> 1)) % nM;
        return true;
    }
    __device__ __forceinline__ void a_ready(const Unit&) const {}
    __device__ __forceinline__ void done(const Unit&) const {}
};
__device__ __forceinline__ unsigned cvt_pk_bf16(float lo, float hi) { unsigned r; asm volatile("v_cvt_pk_bf16_f32 %0, %1, %2" : "=v"(r) : "v"(lo), "v"(hi)); return r; }
template <class Epi, class Sched, bool ALIGN_EPI = false, bool SP2 = false>
__device__ __forceinline__ void gemm_phase(PG8_LAS unsigned char* lds, const Gemm g, const Sched& S, const Epi& E) {
    int tid_ = threadIdx.x; asm volatile("" : "+v"(tid_));
    const int tid = tid_, wid = __builtin_amdgcn_readfirstlane(tid >> 6), lane = tid & 63, wr = wid >> 2, wc = wid & 3, fr = lane & 15, fq = lane >> 4;
    const int K = g.K, nt = K / BK;
    unsigned voffA[2], voffB[2];
#pragma unroll
    for (int i = 0; i < 2; ++i) { int R, C; stage_rc(tid * 16 + i * 8192, R, C); const int Rb = Epi::PERM ? ((R & ~31) + perm32(R & 31)) : R;
        voffA[i] = (unsigned)(R * g.lda + C) * 2u; voffB[i] = (unsigned)(Rb * g.ldb + C) * 2u; }
    const size_t kstepA = g.kstepA, kstepB = g.kstepB;
    const size_t hstepA = (size_t)HALF * g.lda * 2, hstepB = (size_t)HALF * g.ldb * 2;
    const size_t tstepA = 2 * hstepA, tstepB = 2 * hstepB;
    const unsigned ldsw = (unsigned)wid * 1024u;
    const int aoff = lds_byte(wr * 64 + fr, fq * 8), boff = lds_byte(wc * 32 + fr, fq * 8);
#define PG8_SA(b, h) (((b) * 2 + (h)) * HTB)
#define PG8_SB(b, h) ((4 + (b) * 2 + (h)) * HTB)
#define PG8_STAGE(bufoff, gbase, voff) do { _Pragma("unroll") for (int _i = 0; _i < 2; ++_i) \
        __builtin_amdgcn_global_load_lds((const unsigned*)((const char*)(gbase) + (voff)[_i]), (PG8_LAS unsigned*)(lds + (bufoff) + ldsw + _i * 8192), 16, 0, 0); } while (0)
#define PG8_LDA(dst, b, h) do { _Pragma("unroll") for (int m = 0; m < 4; ++m) _Pragma("unroll") for (int k = 0; k < 2; ++k) dst[m][k] = *(const PG8_LAS bf16x8*)(lds + PG8_SA(b, h) + aoff + m * 2048 + k * 1024); } while (0)
#define PG8_LDB(dst, b, h) do { _Pragma("unroll") for (int n = 0; n < 2; ++n) _Pragma("unroll") for (int k = 0; k < 2; ++k) dst[n][k] = *(const PG8_LAS bf16x8*)(lds + PG8_SB(b, h) + boff + n * 2048 + k * 1024); } while (0)
#define PG8_MMA(ai, bj, At, Bt) do { __builtin_amdgcn_s_setprio(1); _Pragma("unroll") for (int m = 0; m < 4; ++m) _Pragma("unroll") for (int n = 0; n < 2; ++n) _Pragma("unroll") for (int k = 0; k < 2; ++k) \
        acc[ai][bj][m][n] = __builtin_amdgcn_mfma_f32_16x16x32_bf16(Bt[n][k], At[m][k], acc[ai][bj][m][n], 0, 0, 0); __builtin_amdgcn_s_setprio(0); } while (0)
#define PG8_WAIT_V(n) asm volatile("s_waitcnt vmcnt(" #n ")" ::: "memory")
#define PG8_WAIT_L(n) asm volatile("s_waitcnt lgkmcnt(" #n ")" ::: "memory")
#define PG8_BAR __builtin_amdgcn_s_barrier()
#define PG8_SCHED __builtin_amdgcn_sched_barrier(0)
    Unit cur, nxt; int ui = 0;
    if (!S.next(0, cur)) return;
    f32x4 acc[2][2][4][2];
#pragma unroll
    for (int a = 0; a < 2; ++a)
#pragma unroll
        for (int b = 0; b < 2; ++b)
#pragma unroll
            for (int m = 0; m < 4; ++m)
#pragma unroll
                for (int n = 0; n < 2; ++n) acc[a][b][m][n] = (f32x4){0.f, 0.f, 0.f, 0.f};
    bf16x8 At[4][2], B0[2][2], B1[2][2];
    const char* cA = (const char*)g.A + (size_t)cur.pm * tstepA; const char* cB = (const char*)g.Bt + (size_t)cur.pn * tstepB;
    S.a_ready(cur);
    if constexpr (SP2) {
        PG8_STAGE(PG8_SB(0, 0), cB, voffB); PG8_STAGE(PG8_SB(0, 1), cB + hstepB, voffB); PG8_STAGE(PG8_SA(0, 0), cA, voffA); PG8_STAGE(PG8_SA(0, 1), cA + hstepA, voffA);
        if (wr == 1) PG8_BAR;
        PG8_WAIT_V(2); PG8_BAR;
        PG8_STAGE(PG8_SB(1, 0), cB + kstepB, voffB); PG8_STAGE(PG8_SA(1, 0), cA + kstepA, voffA); PG8_STAGE(PG8_SB(1, 1), cB + hstepB + kstepB, voffB);
        PG8_WAIT_V(6); PG8_BAR;
    } else {
        PG8_STAGE(PG8_SB(0, 0), cB, voffB); PG8_STAGE(PG8_SA(0, 0), cA, voffA); PG8_STAGE(PG8_SB(0, 1), cB + hstepB, voffB); PG8_STAGE(PG8_SA(0, 1), cA + hstepA, voffA);
        if (wr == 1) PG8_BAR;
        PG8_WAIT_V(4); PG8_BAR;
        PG8_STAGE(PG8_SB(1, 0), cB + kstepB, voffB); PG8_STAGE(PG8_SA(1, 0), cA + kstepA, voffA); PG8_STAGE(PG8_SB(1, 1), cB + hstepB + kstepB, voffB);
        PG8_WAIT_V(6); PG8_BAR;
    }
    for (;;) {
        const bool has_next = S.next(ui + 1, nxt);
        const char* nA = has_next ? (const char*)g.A + (size_t)nxt.pm * tstepA : cA; const char* nB = has_next ? (const char*)g.Bt + (size_t)nxt.pn * tstepB : cB;
        for (int t = 0; t < nt; t += 2) {
            const bool last = (t == nt - 2);
            const char* a1 = cA + (size_t)(t + 1) * kstepA;
            const char* a2 = last ? nA : cA + (size_t)(t + 2) * kstepA; const char* b2 = last ? nB : cB + (size_t)(t + 2) * kstepB;
            const char* a3 = a2 + kstepA; const char* b3 = b2 + kstepB;
            if (last && has_next) S.a_ready(nxt);
            if constexpr (SP2) {
            PG8_LDB(B0, 0, 0); PG8_LDB(B1, 0, 1); PG8_SCHED; PG8_LDA(At, 0, 0); PG8_STAGE(PG8_SA(1, 1), a1 + hstepA, voffA);
            PG8_WAIT_V(8); PG8_WAIT_L(0); PG8_BAR; PG8_MMA(0, 0, At, B0); PG8_MMA(0, 1, At, B1); PG8_BAR; PG8_SCHED;
            PG8_LDA(At, 0, 1); PG8_STAGE(PG8_SB(0, 0), b2, voffB); PG8_STAGE(PG8_SB(0, 1), b2 + hstepB, voffB); PG8_STAGE(PG8_SA(0, 0), a2, voffA);
            PG8_WAIT_V(8); PG8_WAIT_L(0); PG8_BAR; PG8_MMA(1, 0, At, B0); PG8_MMA(1, 1, At, B1); PG8_BAR; PG8_SCHED;
            PG8_LDB(B0, 1, 0); PG8_LDB(B1, 1, 1); PG8_SCHED; PG8_LDA(At, 1, 0); PG8_STAGE(PG8_SA(0, 1), a2 + hstepA, voffA);
            PG8_WAIT_V(8); PG8_WAIT_L(0); PG8_BAR; PG8_MMA(0, 0, At, B0); PG8_MMA(0, 1, At, B1); PG8_BAR; PG8_SCHED;
            PG8_LDA(At, 1, 1); PG8_STAGE(PG8_SB(1, 0), b3, voffB); PG8_STAGE(PG8_SB(1, 1), b3 + hstepB, voffB); PG8_STAGE(PG8_SA(1, 0), a3, voffA);
            PG8_WAIT_V(8); PG8_WAIT_L(0); PG8_BAR; PG8_MMA(1, 0, At, B0); PG8_MMA(1, 1, At, B1); PG8_BAR; PG8_SCHED;
            } else {
            PG8_LDB(B0, 0, 0); PG8_SCHED; PG8_LDA(At, 0, 0); PG8_STAGE(PG8_SA(1, 1), a1 + hstepA, voffA);
            PG8_WAIT_L(8); PG8_BAR; PG8_WAIT_L(0); PG8_MMA(0, 0, At, B0); PG8_BAR; PG8_SCHED;
            PG8_LDB(B1, 0, 1); PG8_STAGE(PG8_SB(0, 0), b2, voffB);
            PG8_BAR; PG8_WAIT_L(0); PG8_MMA(0, 1, At, B1); PG8_BAR;
            PG8_LDA(At, 0, 1); PG8_STAGE(PG8_SA(0, 0), a2, voffA);
            PG8_BAR; PG8_WAIT_L(0); PG8_MMA(1, 0, At, B0); PG8_BAR; PG8_SCHED;
            PG8_STAGE(PG8_SB(0, 1), b2 + hstepB, voffB);
            PG8_WAIT_V(6); PG8_BAR; PG8_MMA(1, 1, At, B1); PG8_BAR;
            PG8_LDB(B0, 1, 0); PG8_SCHED; PG8_LDA(At, 1, 0); PG8_STAGE(PG8_SA(0, 1), a2 + hstepA, voffA);
            PG8_WAIT_L(8); PG8_BAR; PG8_WAIT_L(0); PG8_MMA(0, 0, At, B0); PG8_BAR; PG8_SCHED;
            PG8_LDB(B1, 1, 1); PG8_STAGE(PG8_SB(1, 0), b3, voffB);
            PG8_BAR; PG8_WAIT_L(0); PG8_MMA(0, 1, At, B1); PG8_BAR;
            PG8_LDA(At, 1, 1); PG8_STAGE(PG8_SA(1, 0), a3, voffA);
            PG8_BAR; PG8_WAIT_L(0); PG8_MMA(1, 0, At, B0); PG8_BAR; PG8_SCHED;
            PG8_STAGE(PG8_SB(1, 1), b3 + hstepB, voffB);
            PG8_WAIT_V(6); PG8_BAR; PG8_MMA(1, 1, At, B1); PG8_BAR;
            }
        }
        if constexpr (ALIGN_EPI) { if (wr == 0) PG8_BAR; }
        if constexpr (!Epi::AFTER_DRAIN) { E(acc, cur, wr, wc, fr, fq); S.done(cur); }
        if (!has_next) break;
#pragma unroll
        for (int a = 0; a < 2; ++a)
#pragma unroll
            for (int b = 0; b < 2; ++b)
#pragma unroll
                for (int m = 0; m < 4; ++m)
#pragma unroll
                    for (int n = 0; n < 2; ++n) acc[a][b][m][n] = (f32x4){0.f, 0.f, 0.f, 0.f};
        cur = nxt; cA = nA; cB = nB; ++ui;
        if constexpr (ALIGN_EPI) { if (wr == 1) PG8_BAR; }
    }
    PG8_WAIT_V(0);
    if constexpr (!ALIGN_EPI) { if (wr == 0) PG8_BAR; }
    PG8_BAR;
    if constexpr (Epi::AFTER_DRAIN) { E.fused(acc, cur, wr, wc, fr, fq, lds, wid, lane); S.done(cur); }
#undef PG8_SA
#undef PG8_SB
#undef PG8_STAGE
#undef PG8_LDA
#undef PG8_LDB
#undef PG8_MMA
#undef PG8_WAIT_V
#undef PG8_WAIT_L
#undef PG8_BAR
#undef PG8_SCHED
}
}

#define GAS __attribute__((address_space(1)))
#define LAS __attribute__((address_space(3)))
typedef unsigned short bf16;
typedef unsigned v4u __attribute__((ext_vector_type(4)));
typedef unsigned v2u __attribute__((ext_vector_type(2)));
typedef float f32x4 __attribute__((ext_vector_type(4)));
typedef float f32x2 __attribute__((ext_vector_type(2)));
typedef short bf16x8 __attribute__((ext_vector_type(8)));
typedef short s16x4 __attribute__((ext_vector_type(4)));
typedef float f32x16 __attribute__((ext_vector_type(16)));

constexpr int DM = 2048, FF = 5632, NTOK = 16384, NCTX = 8192, NIN = 3392, NINP = 3584, NMOD = 18432, NQ = 1536;
constexpr int NKVROWS = 20480;
constexpr float EPS = 1e-6f;
constexpr size_t O_Y = 0, O_CKV = 33554432, O_KR = 37748736, O_NAK = 38797312, O_NAV = 47185920, O_GK = 55574528, O_GV = 59768832;
constexpr size_t MiB = 1u << 20;
constexpr size_t WS_CTL = 0, CTL_ZERO_BYTES = 64 * 1024;
constexpr size_t WS_MODS = 1 * MiB;
constexpr size_t WS_ROPE = 3 * MiB;
constexpr size_t WS_WGU = 4 * MiB;
constexpr size_t WS_WD = 1046 * MiB;
constexpr size_t WS_WIN = 268 * MiB;
constexpr size_t WS_WQB = 296 * MiB;
constexpr size_t WS_WKVB = 299 * MiB;
constexpr size_t WS_WOUT = 301 * MiB;
constexpr size_t WS_X = 317 * MiB;
constexpr size_t WS_H = 445 * MiB;
constexpr size_t WS_ACT = 509 * MiB;
constexpr size_t WS_CQN = 733 * MiB;
constexpr size_t WS_CKVN = 749 * MiB;
constexpr size_t WS_QMLA = 759 * MiB;
constexpr size_t WS_KNC = 807 * MiB;
constexpr size_t WS_VMC = 823 * MiB;
constexpr size_t WS_KRC = 839 * MiB;
constexpr size_t WS_KNL = 840 * MiB;
constexpr size_t WS_VML = 864 * MiB;
constexpr size_t WS_KRL = 888 * MiB;
constexpr size_t WS_NAQ = 890 * MiB;
constexpr size_t WS_NAKC = 906 * MiB;
constexpr size_t WS_NAVC = 914 * MiB;
constexpr size_t WS_NAKL = 922 * MiB;
constexpr size_t WS_NAVL = 934 * MiB;
constexpr size_t WS_GQ = 946 * MiB;
constexpr size_t WS_GKC = 962 * MiB;
constexpr size_t WS_GVC = 966 * MiB;
constexpr size_t WS_GKL = 970 * MiB;
constexpr size_t WS_GVL = 976 * MiB;
constexpr size_t WS_O = 982 * MiB;
constexpr size_t WS_END = 1134 * MiB;
constexpr int CW_Q0 = 256, CW_Q1 = 512;
constexpr int CW_BAR = 4096;
constexpr int LDS_MISC = 131072;
constexpr int LDS_BYTES = 132096;

__device__ __forceinline__ unsigned pk2(float lo, float hi) { unsigned r; asm("v_cvt_pk_bf16_f32 %0, %1, %2" : "=v"(r) : "v"(lo), "v"(hi)); return r; }
__device__ __forceinline__ bf16 f2bf(float f) { unsigned u = __builtin_bit_cast(unsigned, f); return (bf16)((u + 0x7fffu + ((u >> 16) & 1u)) >> 16); }
template <int X> __device__ __forceinline__ float swz_xor(float v) { return __builtin_bit_cast(float, __builtin_amdgcn_ds_swizzle(__builtin_bit_cast(int, v), (X << 10) | 0x1f)); }
__device__ __forceinline__ float half_sum(float v) {
    v += swz_xor<1>(v); v += swz_xor<2>(v); v += swz_xor<4>(v); v += swz_xor<8>(v); v += swz_xor<16>(v); return v;
}
__device__ __forceinline__ float wave_sum(float v) {
    v = half_sum(v);
    const unsigned u = __builtin_bit_cast(unsigned, v); auto rr = __builtin_amdgcn_permlane32_swap(u, u, false, false);
    return __builtin_bit_cast(float, (unsigned)rr[0]) + __builtin_bit_cast(float, (unsigned)rr[1]);
}
__device__ __forceinline__ float dot4(f32x4 a) { return (a.x * a.x + a.y * a.y) + (a.z * a.z + a.w * a.w); }
__device__ __forceinline__ float silu_f(float x) { return x * __builtin_amdgcn_rcpf(1.0f + __builtin_amdgcn_exp2f(-1.4426950408889634f * x)); }
__device__ __forceinline__ f32x4 b4f(v2u w) { f32x4 r; r.x = __builtin_bit_cast(float, w.x << 16); r.y = __builtin_bit_cast(float, w.x & 0xffff0000u); r.z = __builtin_bit_cast(float, w.y << 16); r.w = __builtin_bit_cast(float, w.y & 0xffff0000u); return r; }
__device__ __forceinline__ f32x4 ldb4(const bf16* p) { return b4f(*(const v2u*)p); }
__device__ __forceinline__ float ldb1(const bf16* p) { return __builtin_bit_cast(float, (unsigned)*p << 16); }
__device__ __forceinline__ v2u pk4(f32x4 v) { v2u w; w.x = pk2(v.x, v.y); w.y = pk2(v.z, v.w); return w; }

#ifndef OUT_NT
#define OUT_NT 0
#endif
#if OUT_NT
#define OUT_STORE(p, v) __builtin_nontemporal_store((v), (p))
#else
#define OUT_STORE(p, v) (*(p) = (v))
#endif
struct Args { const float* in[26]; float* out; unsigned char* ws; int ph_lo, ph_hi; };
typedef const __attribute__((address_space(4))) Args* KArgsP;
__device__ __forceinline__ KArgsP kargs() { KArgsP p = (KArgsP)__builtin_amdgcn_kernarg_segment_ptr(); asm volatile("" : "+s"(p)); return p; }
__device__ __forceinline__ unsigned char* ws_base() { return kargs()->ws; }
__device__ __forceinline__ const float* in_ptr(int i) { return kargs()->in[i]; }
#define WSP(T, off) ((T*)(ws_base() + (off)))
#define INP(i) in_ptr(i)
#define OUTP() (kargs()->out)
__device__ __forceinline__ int opaque_bx() { int t = blockIdx.x; asm volatile("" : "+s"(t)); return t; }
__device__ __forceinline__ int opaque_tid() { int t = threadIdx.x; asm volatile("" : "+v"(t)); return t; }
enum { I_XP = 0, I_XS, I_CCKV, I_CKR, I_CNAK, I_CNAV, I_CGK, I_CGV, I_C, I_CCTX, I_ADAW, I_ADAB, I_NORMG, I_WG, I_WU, I_WD, I_WIN, I_QNORM, I_WQB, I_KVNORM, I_WKVB, I_RPB, I_GQN, I_GKN, I_WOUT, I_FNORM };

#ifndef ACT_NT
#define ACT_NT 1
#endif
#if ACT_NT
#define ACT_STORE(p, v) __builtin_nontemporal_store((v), (p))
#else
#define ACT_STORE(p, v) (*(p) = (v))
#endif
struct EpiSwiglu {
    static constexpr bool PERM = true, AFTER_DRAIN = false;
    bf16* act;
    __device__ __forceinline__ void operator()(const pg8::f32x4 (&acc)[2][2][4][2], const pg8::Unit& u, int wr, int wc, int fr, int fq) const {
        const int row0 = u.pm * 256 + wr * 64 + fr, col0 = u.pn * 128 + wc * 32 + 8 * fq;
        float zopq = 0.f; asm("" : "+v"(zopq));
#pragma unroll
        for (int ai = 0; ai < 2; ++ai)
#pragma unroll
            for (int m = 0; m < 4; ++m) {
                const pg8::f32x4 t0 = acc[ai][0][m][0], t1 = acc[ai][0][m][1], u0 = acc[ai][1][m][0], u1 = acc[ai][1][m][1];
                float e[8], y[8];
#pragma unroll
                for (int j = 0; j < 4; ++j) { e[j] = __builtin_amdgcn_exp2f(t0[j]); e[4 + j] = __builtin_amdgcn_exp2f(t1[j]); }
#pragma unroll
                for (int j = 0; j < 8; ++j) e[j] = e[j] + 1.0f;
#pragma unroll
                for (int j = 0; j < 8; ++j) e[j] = __builtin_amdgcn_rcpf(e[j]);
#pragma unroll
                for (int j = 0; j < 4; ++j) { const float p0 = (j & 1) ? __builtin_fmaf(t0[j], u0[j], zopq) : t0[j] * u0[j], p1 = (j & 1) ? __builtin_fmaf(t1[j], u1[j], zopq) : t1[j] * u1[j]; y[j] = p0 * e[j]; y[4 + j] = p1 * e[4 + j]; }
                v4u w; w.x = pk2(y[0], y[1]); w.y = pk2(y[2], y[3]); w.z = pk2(y[4], y[5]); w.w = pk2(y[6], y[7]);
                ACT_STORE((v4u*)(act + ((size_t)(col0 >> 6) * NTOK + (row0 + ai * 128 + m * 16)) * 64 + (col0 & 63)), w);
            }
    }
};
#ifndef X_NT
#define X_NT 1
#endif
#if X_NT
#define X_STORE(p, v) __builtin_nontemporal_store((v), (p))
#else
#define X_STORE(p, v) (*(p) = (v))
#endif
struct EpiResid {
    static constexpr bool PERM = true, AFTER_DRAIN = false;
    const bf16* xin; bf16* xout; const float* gate; float fac;
    __device__ __forceinline__ void operator()(const pg8::f32x4 (&acc)[2][2][4][2], const pg8::Unit& u, int wr, int wc, int fr, int fq) const {
        const int row0 = u.pm * 256 + wr * 64 + fr, col0 = u.pn * 256 + wc * 32 + 8 * fq;
        const int cb = u.pm < 32 ? 8 : ((u.pm - 32) >> 2);
        const float* gp = gate + (size_t)cb * NMOD + col0;
        pg8::f32x4 gv[2][2];
#pragma unroll
        for (int bj = 0; bj < 2; ++bj)
#pragma unroll
            for (int n = 0; n < 2; ++n) gv[bj][n] = *(const pg8::f32x4*)(gp + bj * 128 + 4 * n) * fac;
#pragma unroll
        for (int ai = 0; ai < 2; ++ai) {
            v4u xv[4][2];
#pragma unroll
            for (int m = 0; m < 4; ++m) { const size_t off = (size_t)(row0 + ai * 128 + m * 16) * DM + col0;
#pragma unroll
                for (int bj = 0; bj < 2; ++bj) xv[m][bj] = *(const v4u*)(xin + off + bj * 128); }
#pragma unroll
            for (int m = 0; m < 4; ++m) { const size_t off = (size_t)(row0 + ai * 128 + m * 16) * DM + col0;
#pragma unroll
                for (int bj = 0; bj < 2; ++bj) { const v4u x = xv[m][bj];
                    const pg8::f32x4 y0 = b4f((v2u){x.x, x.y}) + gv[bj][0] * acc[ai][bj][m][0], y1 = b4f((v2u){x.z, x.w}) + gv[bj][1] * acc[ai][bj][m][1];
                    v4u w; w.x = pk2(y0[0], y0[1]); w.y = pk2(y0[2], y0[3]); w.z = pk2(y1[0], y1[1]); w.w = pk2(y1[2], y1[3]);
                    X_STORE((v4u*)(xout + off + bj * 128), w); } }
        }
    }
};
struct EpiMix {
    static constexpr bool PERM = true, AFTER_DRAIN = false;
    bf16* C; int ldc;
    bf16 *naq, *nakC, *navC, *nakL, *navL, *gvC, *gvL; float *oNAK, *oNAV, *oGV;
    __device__ __forceinline__ void operator()(const pg8::f32x4 (&acc)[2][2][4][2], const pg8::Unit& u, int wr, int wc, int fr, int fq) const {
        const int r0 = wr * 64 + fr, cw = wc * 32 + 8 * fq;
        const bool ctx = u.pm < 32; const int q = u.pm - 32;
        const size_t grow0 = (size_t)u.pm * 256;
        const size_t lrow0 = ctx ? 0 : (size_t)(q >> 2) * 1536 + 512 + (size_t)(q & 3) * 256;
        const size_t orow0 = (size_t)u.pm * 512;
        const int pn = u.pn;
        int kind = 0; bf16* bdst = C; float* odst = nullptr; int width = ldc, cbase = pn * 256; size_t brow0 = grow0;
        if (pn >= 3 && pn <= 4) { kind = 1; bdst = naq; width = 512; cbase = (pn - 3) * 256; }
        else if (pn >= 5 && pn <= 6) { kind = 2; bdst = ctx ? nakC : nakL; odst = oNAK; width = 512; cbase = (pn - 5) * 256; brow0 = ctx ? grow0 : lrow0; }
        else if (pn >= 7 && pn <= 8) { kind = 2; bdst = ctx ? navC : navL; odst = oNAV; width = 512; cbase = (pn - 7) * 256; brow0 = ctx ? grow0 : lrow0; }
        else if (pn == 12) { kind = 2; bdst = ctx ? gvC : gvL; odst = oGV; width = 256; cbase = 0; brow0 = ctx ? grow0 : lrow0; }
#pragma unroll
        for (int ai = 0; ai < 2; ++ai)
#pragma unroll
            for (int m = 0; m < 4; ++m) {
                const int r = r0 + ai * 128 + m * 16;
                bf16* rowp = bdst + (brow0 + r) * width + cbase + cw;
#pragma unroll
                for (int bj = 0; bj < 2; ++bj) { const pg8::f32x4 v0 = acc[ai][bj][m][0], v1 = acc[ai][bj][m][1];
                    v4u w; w.x = pk2(v0[0], v0[1]); w.y = pk2(v0[2], v0[3]); w.z = pk2(v1[0], v1[1]); w.w = pk2(v1[2], v1[3]);
                    *(v4u*)(rowp + bj * 128) = w;
                    if (kind == 2 && ctx) { float* op = odst + (orow0 + r) * width + cbase + cw + bj * 128; OUT_STORE((pg8::f32x4*)op, v0); OUT_STORE((pg8::f32x4*)(op + 4), v1); } }
            }
    }
};
struct EpiQRope {
    static constexpr bool PERM = true, AFTER_DRAIN = false;
    bf16* Q; const f32x2* r64;
    __device__ __forceinline__ void operator()(const pg8::f32x4 (&acc)[2][2][4][2], const pg8::Unit& u, int wr, int wc, int fr, int fq) const {
        const int row0 = u.pm * 256 + wr * 64 + fr;
#pragma unroll
        for (int bj = 0; bj < 2; ++bj) {
            const int c8 = u.pn * 256 + bj * 128 + wc * 32 + 8 * fq, h = c8 / 192, d = c8 - h * 192;
            const bool rope = (d >= 128) && (u.pm >= 32);
            const int j0 = d - 128, a = j0 >> 5, i0 = (j0 & 31) >> 1;
            pg8::f32x4 cs[2][4][2];
            if (rope) {
#pragma unroll
                for (int ai = 0; ai < 2; ++ai)
#pragma unroll
                    for (int m = 0; m < 4; ++m) { const int t = (row0 + ai * 128 + m * 16 - NCTX) & 1023, pos = a ? (t & 63) : (t >> 6);
                        const pg8::f32x4* tp = (const pg8::f32x4*)(r64 + pos * 16 + i0); cs[ai][m][0] = tp[0]; cs[ai][m][1] = tp[1]; }
            }
#pragma unroll
            for (int ai = 0; ai < 2; ++ai)
#pragma unroll
                for (int m = 0; m < 4; ++m) {
                    const int row = row0 + ai * 128 + m * 16;
                    pg8::f32x4 v0 = acc[ai][bj][m][0], v1 = acc[ai][bj][m][1];
                    if (rope) {
                        const pg8::f32x4 c01 = cs[ai][m][0], c23 = cs[ai][m][1];
                        pg8::f32x4 y0, y1;
                        y0[0] = v0[0] * c01[0] - v0[1] * c01[1]; y0[1] = v0[1] * c01[0] + v0[0] * c01[1];
                        y0[2] = v0[2] * c01[2] - v0[3] * c01[3]; y0[3] = v0[3] * c01[2] + v0[2] * c01[3];
                        y1[0] = v1[0] * c23[0] - v1[1] * c23[1]; y1[1] = v1[1] * c23[0] + v1[0] * c23[1];
                        y1[2] = v1[2] * c23[2] - v1[3] * c23[3]; y1[3] = v1[3] * c23[2] + v1[2] * c23[3];
                        v0 = y0; v1 = y1;
                    }
                    v4u w; w.x = pk2(v0[0], v0[1]); w.y = pk2(v0[2], v0[3]); w.z = pk2(v1[0], v1[1]); w.w = pk2(v1[2], v1[3]);
                    *(v4u*)(Q + (size_t)row * NQ + c8) = w;
                }
        }
    }
};
struct EpiKV {
    static constexpr bool PERM = true, AFTER_DRAIN = false;
    bf16 *knC, *vC, *knL, *vL;
    __device__ __forceinline__ void operator()(const pg8::f32x4 (&acc)[2][2][4][2], const pg8::Unit& u, int wr_, int wc_, int fr_, int fq_) const {
        const int t2 = opaque_tid(), wid2 = __builtin_amdgcn_readfirstlane(t2 >> 6), wr = wid2 >> 2, wc = wid2 & 3, fr = t2 & 15, fq = (t2 & 63) >> 4;
        (void)wr_; (void)wc_; (void)fr_; (void)fq_;
        bf16 *kb, *vb; int drow0;
        if (u.pm < 32) { kb = knC; vb = vC; drow0 = u.pm * 256; }
        else if (u.pm < 64) { const int q = u.pm - 32; kb = knL; vb = vL; drow0 = (q >> 2) * 1536 + 512 + (q & 3) * 256; }
        else { const int q = u.pm - 64; kb = knL; vb = vL; drow0 = (q >> 1) * 1536 + (q & 1) * 256; }
        const int col0 = u.pn * 128 + wc * 32 + 8 * fq;
#pragma unroll
        for (int ai = 0; ai < 2; ++ai)
#pragma unroll
            for (int m = 0; m < 4; ++m) {
                const size_t off = (size_t)(drow0 + wr * 64 + fr + ai * 128 + m * 16) * 1024 + col0;
#pragma unroll
                for (int bj = 0; bj < 2; ++bj) {
                    const pg8::f32x4 v0 = acc[ai][bj][m][0], v1 = acc[ai][bj][m][1];
                    v4u w; w.x = pk2(v0[0], v0[1]); w.y = pk2(v0[2], v0[3]); w.z = pk2(v1[0], v1[1]); w.w = pk2(v1[2], v1[3]);
                    *(v4u*)((bj ? vb : kb) + off) = w;
                }
            }
    }
};

namespace att {
constexpr float THR = 8.f;
constexpr int SHM_V = 16384, SHM_K = 16384, SHM_R = 8192;
constexpr int OFF_V = 0, OFF_K = 32768, OFF_R = 65536, OFF_WS = 81920, OFF_T = 83968, OFF_PEN = 91648, OFF_BC = 92160, OFF_QR = 92672;
#define KSWZ(row, colB) ((row) * 256 + ((colB) ^ (((row) & 7) << 4)))
#define RSWZ(row, colB) ((row) * 128 + ((colB) ^ (((row) & 7) << 4)))
#define SBAR() __builtin_amdgcn_sched_barrier(0)
__device__ __forceinline__ int crow(int r, int hi) { return (r & 3) + 8 * (r >> 2) + 4 * hi; }
__device__ __forceinline__ unsigned cvtpk(float lo, float hi) { unsigned r; asm volatile("v_cvt_pk_bf16_f32 %0, %1, %2" : "=v"(r) : "v"(lo), "v"(hi)); return r; }

template <int DK> __device__ __forceinline__ void partialSM(f32x16& p0, f32x16& p1, float& m_reg, float& mn, float& alpha) {
  constexpr float SCALE = (DK == 192) ? 0.07216878364870323f : 0.08838834764831845f;
  constexpr float C = SCALE * 1.4426950408889634f;
  float pmax = p0[0];
#pragma unroll
  for (int r = 1; r < 16; ++r) pmax = fmaxf(pmax, p0[r]);
#pragma unroll
  for (int r = 0; r < 16; ++r) pmax = fmaxf(pmax, p1[r]);
  { auto rr = __builtin_amdgcn_permlane32_swap(__float_as_uint(pmax), __float_as_uint(pmax), false, false);
    pmax = fmaxf(__uint_as_float(rr[0]), __uint_as_float(rr[1])); }
  if (__builtin_expect(__all(pmax - m_reg <= THR / SCALE), 1)) { mn = m_reg; alpha = 1.f; }
  else { mn = fmaxf(m_reg, pmax); alpha = __builtin_amdgcn_exp2f((m_reg - mn) * C); m_reg = mn; }
  const float mnC = -mn * C;
#pragma unroll
  for (int r = 0; r < 16; ++r) p0[r] = fmaf(p0[r], C, mnC);
#pragma unroll
  for (int r = 0; r < 16; ++r) p1[r] = fmaf(p1[r], C, mnC);
#pragma unroll
  for (int r = 0; r < 16; ++r) p0[r] = __builtin_amdgcn_exp2f(p0[r]);
}
__device__ __forceinline__ void finishSM(f32x16& p0, f32x16& p1, float alpha, float& l_reg, bf16x8& pa0, bf16x8& pa1, bf16x8& pa2, bf16x8& pa3) {
#pragma unroll
  for (int r = 0; r < 16; ++r) p1[r] = __builtin_amdgcn_exp2f(p1[r]);
  float ps = 0;
#pragma unroll
  for (int r = 0; r < 16; ++r) ps += p0[r];
#pragma unroll
  for (int r = 0; r < 16; ++r) ps += p1[r];
  { auto rr = __builtin_amdgcn_permlane32_swap(__float_as_uint(ps), __float_as_uint(ps), false, false);
    ps = __uint_as_float(rr[0]) + __uint_as_float(rr[1]); }
  l_reg = l_reg * alpha + ps;
#define PK4(P, BASE, OUT) do { unsigned a0 = cvtpk(P[BASE + 0], P[BASE + 1]), a1 = cvtpk(P[BASE + 2], P[BASE + 3]);   \
    unsigned b0 = cvtpk(P[BASE + 4], P[BASE + 5]), b1 = cvtpk(P[BASE + 6], P[BASE + 7]);                              \
    auto r0 = __builtin_amdgcn_permlane32_swap(a0, b0, false, false); auto r1 = __builtin_amdgcn_permlane32_swap(a1, b1, false, false); \
    v4u w = {r0[0], r1[0], r0[1], r1[1]}; OUT = *reinterpret_cast<bf16x8*>(&w); } while (0)
  PK4(p0, 0, pa0); PK4(p0, 8, pa1); PK4(p1, 0, pa2); PK4(p1, 8, pa3);
#undef PK4
}
template <int DK, int NREG> __device__ __forceinline__ void qkt(f32x16& p0, f32x16& p1, const char* Ks, const char* Rs, const bf16x8* qr, const char* qrl, int r32, int hi) {
  p0 = f32x16{}; p1 = f32x16{};
#pragma unroll
  for (int d0 = 0; d0 < 8; ++d0) { const int cb = (d0 * 16 + hi * 8) * 2;
    const bf16x8 b0 = *reinterpret_cast<const bf16x8*>(Ks + KSWZ(r32, cb));
    const bf16x8 b1 = *reinterpret_cast<const bf16x8*>(Ks + KSWZ(32 + r32, cb));
    bf16x8 q; if constexpr (true) { if (d0 < NREG) q = qr[d0 < NREG ? d0 : 0]; else q = *reinterpret_cast<const bf16x8*>(qrl + (d0 - NREG) * 1024); }
    p0 = __builtin_amdgcn_mfma_f32_32x32x16_bf16(b0, q, p0, 0, 0, 0);
    p1 = __builtin_amdgcn_mfma_f32_32x32x16_bf16(b1, q, p1, 0, 0, 0); }
  if constexpr (DK == 192) {
#pragma unroll
    for (int d0 = 0; d0 < 4; ++d0) { const int cb = (d0 * 16 + hi * 8) * 2;
      const bf16x8 b0 = *reinterpret_cast<const bf16x8*>(Rs + RSWZ(r32, cb));
      const bf16x8 b1 = *reinterpret_cast<const bf16x8*>(Rs + RSWZ(32 + r32, cb));
      const bf16x8 q = *reinterpret_cast<const bf16x8*>(qrl + (8 + d0 - NREG) * 1024);
      p0 = __builtin_amdgcn_mfma_f32_32x32x16_bf16(b0, q, p0, 0, 0, 0);
      p1 = __builtin_amdgcn_mfma_f32_32x32x16_bf16(b1, q, p1, 0, 0, 0); }
  }
}
__device__ __forceinline__ void na_hook(f32x16& p0, f32x16& p1, bool row_ok, const float* Trow, const float* Prow) {
  if (!row_ok) {
#pragma unroll
    for (int r = 0; r < 16; ++r) { p0[r] = -1e30f; p1[r] = -1e30f; }
  } else {
#pragma unroll
    for (int r = 0; r < 16; ++r) { const int kr = (r & 3) + 8 * (r >> 2);
      p0[r] = (p0[r] + Trow[kr]) + Prow[kr];
      p1[r] = (p1[r] + Trow[kr + 32]) + Prow[kr + 32];
      if (r & 1) asm volatile("" ::: "memory"); }
  }
}
__device__ __forceinline__ int v_st(int k, int c) { const int kk = (k & ~0xC) | ((k & 4) << 1) | ((k & 8) >> 1); return ((kk >> 3) * 4 + (c >> 5)) * 512 + ((kk & 7) * 32 + (c & 31)) * 2; }
__device__ __forceinline__ int v_rd_base(int lane) { return ((lane & 3) << 3) | (((lane >> 2) & 3) << 6) | (((lane >> 4) & 1) << 5) | (((lane >> 5) & 1) << 8); }
constexpr int v_rd_off(int d0, int ks, int half) { return d0 * 512 + ks * 4096 + half * 2048; }
template <int OFF> __device__ __forceinline__ s16x4 tr_read(int vb) {
  s16x4 r; asm volatile("ds_read_b64_tr_b16 %0, %1 offset:%2" : "=&v"(r) : "v"(vb), "i"(OFF) : "memory"); return r;
}
template <int D0> __device__ __forceinline__ void pv_one(f32x16& od, int vb, bf16x8 pa0, bf16x8 pa1, bf16x8 pa2, bf16x8 pa3) {
  const s16x4 l0 = tr_read<v_rd_off(D0, 0, 0)>(vb), h0 = tr_read<v_rd_off(D0, 0, 1)>(vb), l1 = tr_read<v_rd_off(D0, 1, 0)>(vb), h1 = tr_read<v_rd_off(D0, 1, 1)>(vb);
  const s16x4 l2 = tr_read<v_rd_off(D0, 2, 0)>(vb), h2 = tr_read<v_rd_off(D0, 2, 1)>(vb), l3 = tr_read<v_rd_off(D0, 3, 0)>(vb), h3 = tr_read<v_rd_off(D0, 3, 1)>(vb);
  asm volatile("s_waitcnt lgkmcnt(0)" ::: "memory"); SBAR();
#define PK(L, H) (bf16x8){L[0], L[1], L[2], L[3], H[0], H[1], H[2], H[3]}
  od = __builtin_amdgcn_mfma_f32_32x32x16_bf16(pa0, PK(l0, h0), od, 0, 0, 0);
  od = __builtin_amdgcn_mfma_f32_32x32x16_bf16(pa1, PK(l1, h1), od, 0, 0, 0);
  od = __builtin_amdgcn_mfma_f32_32x32x16_bf16(pa2, PK(l2, h2), od, 0, 0, 0);
  od = __builtin_amdgcn_mfma_f32_32x32x16_bf16(pa3, PK(l3, h3), od, 0, 0, 0);
#undef PK
}
__device__ __forceinline__ void pv_d0(f32x16* o, int vb, bf16x8 pa0, bf16x8 pa1, bf16x8 pa2, bf16x8 pa3) {
  pv_one<0>(o[0], vb, pa0, pa1, pa2, pa3); pv_one<1>(o[1], vb, pa0, pa1, pa2, pa3); pv_one<2>(o[2], vb, pa0, pa1, pa2, pa3); pv_one<3>(o[3], vb, pa0, pa1, pa2, pa3);
}

template <int DK, bool HOOK, int SD, int NREG>
__device__ __forceinline__ void attn_unit(const bf16* __restrict__ Qb, const int ldq, const bf16* __restrict__ Kh, const int ldk, const bf16* __restrict__ Rh,
                                          const bf16* __restrict__ Vh, bf16* __restrict__ Obase, const int orow0, const int ocol0,
                                          const int NT, const int nplain, const int loc0, const int r0, const int lo, char* lds) {
  int tid_ = threadIdx.x; asm volatile("" : "+v"(tid_));
  const int tid = tid_, wid = tid >> 6, lane = tid & 63, r32 = lane & 31, hi = lane >> 5;
  char* V_lds = lds + OFF_V; char* K_lds = lds + OFF_K; char* R_lds = lds + OFF_R;
  float* ws = (float*)(lds + OFF_WS) + wid * 64; float* li_l = ws; float* al_l = ws + 32;
  float m_reg = -1e30f, l_reg = 0; f32x16 o[4] = {}; bf16x8 qr[NREG];
  const bf16* Qw = Qb + (long)(wid * 32 + r32) * ldq + hi * 8;
  char* qrl = lds + OFF_QR + wid * 4096 + lane * 16;
  static_assert(DK / 16 - NREG <= 4 && NREG <= 8, "at most four Q fragments per lane in LDS");
#pragma unroll
  for (int d0 = 0; d0 < DK / 16; ++d0) { const bf16x8 v = *reinterpret_cast<const bf16x8*>(Qw + d0 * 16);
    if (d0 < NREG) qr[d0 < NREG ? d0 : 0] = v; else *reinterpret_cast<bf16x8*>(qrl + (d0 - NREG) * 1024) = v; }
  const int sr = tid >> 4, sc = (tid & 15) * 8, vst0 = v_st(sr, sc), vst1 = v_st(32 + sr, sc);
  const int rr = tid >> 3, rc = (tid & 7) * 8;
  const unsigned vo0 = (unsigned)(sr * ldk + sc) * 2u, vo1 = vo0 + (unsigned)ldk * 64u, vor = (unsigned)(rr * 64 + rc) * 2u;
  const int vb0 = (int)(uintptr_t)V_lds + v_rd_base(lane);
  const int grow = r0 + (wid >> 1), rs = min(max(grow - 4, 0), 8);
  const int qc = 32 * (wid & 1) + r32, cs = min(max(qc - 8, 0), 48);
  const float* Tlane = (const float*)(lds + OFF_T) + 48 + 15 - qc + 4 * hi;
  const float* Plane = (const float*)(lds + OFF_PEN) + 63 + 4 * hi - cs;
  struct { bf16x8 vs0, vs1, ks0, ks1, rs; } sr_[SD];
  constexpr int SE = 0, SO = SD - 1;
#define KOFF(j) ((j) < nplain ? (j) * 64 : loc0 + ((j) - nplain) * 64)
#define SLOAD(i, j) do { const int k0_ = KOFF(j); const char* kt_ = (const char*)(Kh + (long)k0_ * ldk); const char* vt_ = (const char*)(Vh + (long)k0_ * ldk); \
    sr_[i].vs0 = *reinterpret_cast<const bf16x8*>(vt_ + vo0); sr_[i].vs1 = *reinterpret_cast<const bf16x8*>(vt_ + vo1); \
    sr_[i].ks0 = *reinterpret_cast<const bf16x8*>(kt_ + vo0); sr_[i].ks1 = *reinterpret_cast<const bf16x8*>(kt_ + vo1); \
    if constexpr (DK == 192) sr_[i].rs = *reinterpret_cast<const bf16x8*>((const char*)(Rh + (long)k0_ * 64) + vor); } while (0)
#define SWRITE(b, i) do { *(bf16x8*)(V_lds + (b) * SHM_V + vst0) = sr_[i].vs0; *(bf16x8*)(V_lds + (b) * SHM_V + vst1) = sr_[i].vs1; const int kc_ = sc * 2; \
    *(bf16x8*)(K_lds + (b) * SHM_K + KSWZ(sr, kc_)) = sr_[i].ks0; *(bf16x8*)(K_lds + (b) * SHM_K + KSWZ(32 + sr, kc_)) = sr_[i].ks1; \
    if constexpr (DK == 192) *(bf16x8*)(R_lds + (b) * SHM_R + RSWZ(rr, rc * 2)) = sr_[i].rs; } while (0)
#define SWAIT() do { if constexpr (SD == 1) asm volatile("s_waitcnt vmcnt(0)" ::: "memory"); else if constexpr (DK == 192) asm volatile("s_waitcnt vmcnt(5)" ::: "memory"); else asm volatile("s_waitcnt vmcnt(4)" ::: "memory"); } while (0)
#define RESC(a) do { if (__any((a) < 1.f)) { if (hi == 0) al_l[r32] = (a); asm volatile("s_waitcnt lgkmcnt(0)" ::: "memory"); \
    _Pragma("unroll") for (int d = 0; d < 4; ++d) _Pragma("unroll") for (int r = 0; r < 16; ++r) o[d][r] *= al_l[crow(r, hi)]; } } while (0)
#define HOOKT(p0, p1, j) do { if constexpr (HOOK) { if ((j) >= nplain) { const int kr_ = lo + (j) - nplain; \
    na_hook(p0, p1, kr_ >= rs && kr_ < rs + 8, Tlane + (kr_ - grow + 7) * 128, Plane); } } } while (0)
  f32x16 pA0, pA1, pB0, pB1; float mnA, mnB, alA, alB; bf16x8 pa0, pa1, pa2, pa3;
  SLOAD(SE, 0); asm volatile("s_waitcnt vmcnt(0)" ::: "memory"); SWRITE(0, SE); __syncthreads();
  qkt<DK, NREG>(pA0, pA1, K_lds, R_lds, qr, qrl, r32, hi); partialSM<DK>(pA0, pA1, m_reg, mnA, alA);
  SLOAD(SO, 1); if constexpr (SD == 2) { if (2 < NT) SLOAD(SE, 2); }
  SWAIT(); SWRITE(1, SO); __syncthreads();
  for (int j = 1; j + 1 < NT; j += 2) {
    SBAR(); qkt<DK, NREG>(pB0, pB1, K_lds + SHM_K, R_lds + SHM_R, qr, qrl, r32, hi); HOOKT(pB0, pB1, j);
    finishSM(pA0, pA1, alA, l_reg, pa0, pa1, pa2, pa3); SBAR();
    SLOAD(SO, j + SD); SBAR();
    pv_d0(o, vb0, pa0, pa1, pa2, pa3); partialSM<DK>(pB0, pB1, m_reg, mnB, alB);
    __syncthreads(); SWAIT(); SWRITE(0, SE);
    RESC(alB); __syncthreads();
    SBAR(); qkt<DK, NREG>(pA0, pA1, K_lds, R_lds, qr, qrl, r32, hi); HOOKT(pA0, pA1, j + 1);
    finishSM(pB0, pB1, alB, l_reg, pa0, pa1, pa2, pa3); SBAR();
    if (SD == 1 || j + 3 < NT) SLOAD(SE, j + 1 + SD); SBAR();
    pv_d0(o, vb0 + SHM_V, pa0, pa1, pa2, pa3); partialSM<DK>(pA0, pA1, m_reg, mnA, alA);
    __syncthreads(); SWAIT(); SWRITE(1, SO);
    RESC(alA); __syncthreads();
  }
  SBAR(); qkt<DK, NREG>(pB0, pB1, K_lds + SHM_K, R_lds + SHM_R, qr, qrl, r32, hi); HOOKT(pB0, pB1, NT - 1);
  finishSM(pA0, pA1, alA, l_reg, pa0, pa1, pa2, pa3); SBAR();
  pv_d0(o, vb0, pa0, pa1, pa2, pa3); partialSM<DK>(pB0, pB1, m_reg, mnB, alB);
  __syncthreads(); RESC(alB);
  finishSM(pB0, pB1, alB, l_reg, pa0, pa1, pa2, pa3); SBAR();
  pv_d0(o, vb0 + SHM_V, pa0, pa1, pa2, pa3);
  if (hi == 0) li_l[r32] = l_reg; asm volatile("s_waitcnt lgkmcnt(0)" ::: "memory");
  float rli[16];
#pragma unroll
  for (int r = 0; r < 16; ++r) rli[r] = __builtin_amdgcn_rcpf(li_l[crow(r, hi)]);
  char* ost = lds + OFF_QR + wid * 4096;
#pragma unroll
  for (int h = 0; h < 2; ++h) {
#pragma unroll
    for (int r = 0; r < 16; ++r) { const int row = crow(r, hi);
#pragma unroll
      for (int dd = 0; dd < 2; ++dd) *(bf16*)(ost + row * 128 + (dd * 32 + r32) * 2) = (bf16)cvtpk(o[2 * h + dd][r] * rli[r], 0.f); }
    asm volatile("s_waitcnt lgkmcnt(0)" ::: "memory");
#pragma unroll
    for (int i = 0; i < 4; ++i) { const int c = i * 64 + lane, row = c >> 3, ch = c & 7;
      const v4u v = *(const v4u*)(ost + row * 128 + ch * 16);
      *(v4u*)(Obase + ((size_t)((ocol0 >> 6) + h) * NTOK + (size_t)(orow0 + wid * 32 + row)) * 64 + ch * 8) = v; }
    asm volatile("s_waitcnt lgkmcnt(0)" ::: "memory");
  }
#undef KOFF
#undef SLOAD
#undef SWRITE
#undef SWAIT
#undef RESC
#undef HOOKT
}
}
#define XB_TMO      128
#define XB_XCNT(j)  (256  + 64 * (j))
#define XB_XSUB(j)  (1280 + 64 * (j))
#define XB_XGEN(j)  (2304 + 64 * (j))
#define XB_TOP      3328
#define XB_TOPGEN   3392
#define XCD_BAR_WORDS 3456
#define XB_SPIN_CAP (1u << 18)

__device__ __forceinline__ unsigned xb_ld(unsigned* p)              { return __hip_atomic_load(p, __ATOMIC_RELAXED, __HIP_MEMORY_SCOPE_AGENT); }
__device__ __forceinline__ unsigned xb_add(unsigned* p, unsigned v) { return __hip_atomic_fetch_add(p, v, __ATOMIC_RELAXED, __HIP_MEMORY_SCOPE_AGENT); }
__device__ __forceinline__ unsigned xb_xcc_id() { return (unsigned)__builtin_amdgcn_s_getreg((3 << 11) | 20) & 0xFu; }
#define XB_SPIN(cond, bar) do { unsigned _sp = 0; while (cond) { __builtin_amdgcn_s_sleep(1); \
    if ((++_sp & 255u) == 0u) { if (xb_ld(&(bar)[XB_TMO])) break; if (_sp > XB_SPIN_CAP) { atomicAdd(&(bar)[XB_TMO], 1u); break; } } } } while (0)

struct XcdBarrier {
    unsigned* bar; unsigned x;
    volatile LAS unsigned* st;
};

__device__ __forceinline__ XcdBarrier xcd_barrier_post(unsigned* bar, volatile LAS unsigned* st) {
    XcdBarrier b; b.bar = bar; b.x = xb_xcc_id(); b.st = st;
    if (threadIdx.x == 0) (void)xb_add(&bar[XB_XCNT(b.x)], 1u);
    return b;
}
__device__ __forceinline__ void xcd_barrier_complete(unsigned* bar, unsigned x, unsigned& nloc, unsigned& nx) {
    const unsigned G = gridDim.x * gridDim.y * gridDim.z;
    unsigned sum, cnt, mine, sp = 0u;
    for (;;) {
        sum = 0u; cnt = 0u; mine = 0u;
#pragma unroll
        for (unsigned j = 0; j < 16; ++j) { const unsigned c = xb_ld(&bar[XB_XCNT(j)]); sum += c; cnt += (c > 0u) ? 1u : 0u; mine = (j == x) ? c : mine; }
        if (sum == G) break;
        __builtin_amdgcn_s_sleep(1);
        if ((++sp & 255u) == 0u) { if (xb_ld(&bar[XB_TMO])) break; if (sp > XB_SPIN_CAP) { atomicAdd(&bar[XB_TMO], 1u); break; } }
    }
    nloc = mine > 0u ? mine : 1u; nx = cnt > 0u ? cnt : 1u;
}

__device__ __forceinline__ void xcd_barrier(const XcdBarrier& b) {
    asm volatile("s_waitcnt vmcnt(0)" ::: "memory");
    __syncthreads();
    if (threadIdx.x == 0) {
        unsigned* bar = b.bar;
        __builtin_amdgcn_s_waitcnt(0);
        unsigned nloc = b.st[0], nx = b.st[1];
        if (nloc == 0u) { xcd_barrier_complete(bar, b.x, nloc, nx); b.st[0] = nloc; b.st[1] = nx; }
        const unsigned old = xb_add(&bar[XB_XSUB(b.x)], 1u);
        const unsigned gen = old / nloc;
        if (old + 1u == (gen + 1u) * nloc) {
            __builtin_amdgcn_fence(__ATOMIC_RELEASE, "agent");
            asm volatile("s_waitcnt vmcnt(0)" ::: "memory");
            const unsigned og = xb_add(&bar[XB_TOP], 1u);
            const unsigned tg = og / nx;
            if (og + 1u == (tg + 1u) * nx) xb_add(&bar[XB_TOPGEN], 1u);
            else XB_SPIN(xb_ld(&bar[XB_TOPGEN]) == tg, bar);
            __builtin_amdgcn_fence(__ATOMIC_ACQUIRE, "agent");
            xb_add(&bar[XB_XGEN(b.x)], 1u);
            asm volatile("s_waitcnt vmcnt(0)" ::: "memory");
        } else {
            XB_SPIN(xb_ld(&bar[XB_XGEN(b.x)]) == gen, bar);
            __builtin_amdgcn_fence(__ATOMIC_ACQUIRE, "agent");
            asm volatile("s_waitcnt vmcnt(0)" ::: "memory");
        }
    }
    __syncthreads();
}

#ifndef IN_NT
#define IN_NT 0
#endif
#if IN_NT
#define IN_LOAD(p) __builtin_nontemporal_load(p)
#else
#define IN_LOAD(p) (*(p))
#endif
template <int MODE> __device__ __forceinline__ int rowmap(int n, int row_off) {
    if (MODE == 1) return ((n >> 7) << 8) + (n & 127) + row_off;
    if (MODE == 2) { const int h = n / 192; int d = n - h * 192; if (d >= 128) { const int t = d - 128, a = t >> 5, p = (t >> 4) & 1, i = t & 15; d = 128 + a * 32 + 2 * i + p; } return h * 192 + d; }
    if (MODE == 3) return n < 768 ? n : (n < 832 ? 3328 + (n - 768) : n - 64);
    return n + row_off;
}
constexpr int WCOPY_NALL = 8 * 32 * 176 + 4 * 88 * 64 + 2 * (32 * 106 + 8 * 48 + 4 * 64 + 32 * 64), WCOPY_NTAIL = 2 * 32 * 176 + 88 * 64, WCOPY_NPRO = WCOPY_NALL - 2 * WCOPY_NTAIL;
template <int SET> __device__ __forceinline__ void wcopy_set(LAS unsigned char* lds, int lf_tail, int v0, int vcnt, int wg, int nwg) {
    const int tid = opaque_tid(), lane = tid & 63, wave = __builtin_amdgcn_readfirstlane(tid >> 6);
    {
        LAS float* scr = (LAS float*)(lds + wave * 8704);
        const int gw = wg * 8 + wave, NGW = nwg * 8;
        constexpr int I_GU = 32 * 176, I_D = 88 * 64, I_IN = 32 * 106, I_QB = 8 * 48, I_KVB = 4 * 64, I_OUT = 32 * 64;
        constexpr int NALL = 8 * I_GU + 4 * I_D + 2 * (I_IN + I_QB + I_KVB + I_OUT), NTAIL = 2 * I_GU + I_D, NITEMS = SET == 0 ? NALL - 2 * NTAIL : NTAIL;
        auto vmap = [&](int v) { if (SET == 0) return v < 2 * I_GU ? v : (v < 4 * I_GU ? v + 2 * I_GU : (v < 4 * I_GU + I_D ? v + 4 * I_GU : (v < 4 * I_GU + 2 * I_D ? v + 4 * I_GU + I_D : v + 4 * I_GU + 2 * I_D)));
                                 return v < 2 * I_GU ? 2 * lf_tail * I_GU + v : 8 * I_GU + lf_tail * I_D + (v - 2 * I_GU); };
        struct Item { const float* src; bf16* dst; int N, trows, mode, row_off, kb, n0; float scale; };
        auto decode = [&](int it, Item& d) {
            int r = it; const float* W; int K, N, item; d.scale = 1.0f;
            if (r < 8 * I_GU) { const int mat = r / I_GU, lf = mat >> 1, up = mat & 1; item = r - mat * I_GU;
                W = INP(up ? I_WU : I_WG) + (size_t)lf * DM * FF; K = DM; N = FF; d.dst = WSP(bf16, WS_WGU) + (size_t)lf * 2 * FF * DM; d.trows = 2 * FF; d.mode = 1; d.row_off = up * 128; d.scale = up ? -0.6931471805599453f : -1.4426950408889634f; }
            else if ((r -= 8 * I_GU) < 4 * I_D) { const int lf = r / I_D; item = r - lf * I_D;
                W = INP(I_WD) + (size_t)lf * FF * DM; K = FF; N = DM; d.dst = WSP(bf16, WS_WD) + (size_t)lf * DM * FF; d.trows = DM; d.mode = 0; d.row_off = 0; }
            else if ((r -= 4 * I_D) < 2 * I_IN) { const int l = r / I_IN; item = r - l * I_IN;
                W = INP(I_WIN) + (size_t)l * DM * NIN; K = DM; N = NIN; d.dst = WSP(bf16, WS_WIN) + (size_t)l * NINP * DM; d.trows = NINP; d.mode = 3; d.row_off = 0; }
            else if ((r -= 2 * I_IN) < 2 * I_QB) { const int l = r / I_QB; item = r - l * I_QB;
                W = INP(I_WQB) + (size_t)l * 512 * NQ; K = 512; N = NQ; d.dst = WSP(bf16, WS_WQB) + (size_t)l * NQ * 512; d.trows = NQ; d.mode = 2; d.row_off = 0; }
            else if ((r -= 2 * I_QB) < 2 * I_KVB) { const int l = r / I_KVB; item = r - l * I_KVB;
                W = INP(I_WKVB) + (size_t)l * 256 * 2048; K = 256; N = 2048; d.dst = WSP(bf16, WS_WKVB) + (size_t)l * 2048 * 256; d.trows = 2048; d.mode = 0; d.row_off = 0; }
            else { r -= 2 * I_KVB; const int l = r / I_OUT; item = r - l * I_OUT;
                W = INP(I_WOUT) + (size_t)l * DM * DM; K = DM; N = DM; d.dst = WSP(bf16, WS_WOUT) + (size_t)l * DM * DM; d.trows = DM; d.mode = 0; d.row_off = 0; }
            (void)K; const int nblk = N / 32; d.kb = item / nblk; d.n0 = 32 * (item - d.kb * nblk); d.N = N; d.src = W + (size_t)(64 * d.kb) * N + d.n0;
        };
        auto load = [&](const Item& d, float (&v)[32]) {
            const float* s = d.src + (size_t)(lane >> 5) * d.N + (lane & 31);
#pragma unroll
            for (int i = 0; i < 32; ++i) v[i] = IN_LOAD(s + (size_t)(2 * i) * d.N);
        };
        Item cur, nxt; float vc[32], vn[32];
        const int vend = v0 + vcnt;
        if (v0 + gw < vend) { decode(vmap(v0 + gw), cur); load(cur, vc); }
        for (int it = v0 + gw; it < vend; it += NGW) {
            const bool more = it + NGW < vend;
            if (more) { decode(vmap(it + NGW), nxt); load(nxt, vn); }
#pragma unroll
            for (int i = 0; i < 32; ++i) scr[(2 * i + (lane >> 5)) * 33 + (lane & 31)] = vc[i];
            asm volatile("s_waitcnt lgkmcnt(0)" ::: "memory");
            const int c = lane & 7;
#pragma unroll
            for (int j = 0; j < 4; ++j) { const int n = (lane >> 3) + 8 * j; const LAS float* s = scr + (8 * c) * 33 + n;
                const float sc = cur.scale;
                v4u o; o.x = pk2(s[0 * 33] * sc, s[1 * 33] * sc); o.y = pk2(s[2 * 33] * sc, s[3 * 33] * sc); o.z = pk2(s[4 * 33] * sc, s[5 * 33] * sc); o.w = pk2(s[6 * 33] * sc, s[7 * 33] * sc);
                const int nn = cur.n0 + n;
                const int drow = cur.mode == 1 ? rowmap<1>(nn, cur.row_off) : (cur.mode == 2 ? rowmap<2>(nn, 0) : (cur.mode == 3 ? rowmap<3>(nn, 0) : nn));
                *(GAS v4u*)(cur.dst + ((size_t)cur.kb * cur.trows + drow) * 64 + 8 * c) = o; }
            asm volatile("s_waitcnt lgkmcnt(0)" ::: "memory");
            if (more) { cur = nxt;
#pragma unroll
                for (int i = 0; i < 32; ++i) vc[i] = vn[i]; }
        }
    }
}
__device__ __forceinline__ void prologue_phase(const Args& A, LAS unsigned char* lds) {
    const int tid = opaque_tid(), lane = tid & 63, wave = __builtin_amdgcn_readfirstlane(tid >> 6), G = gridDim.x;
    {
        LAS float* sil = (LAS float*)lds;
        float* mods = WSP(float, WS_MODS);
        const float* cin = INP(I_C); const float* cctx = INP(I_CCTX); const float* aw = INP(I_ADAW); const float* ab = INP(I_ADAB);
        for (int it = blockIdx.x; it < 256; it += G) {
            for (int e = tid; e < 9 * 2048; e += 512) { const int cb = e >> 11, k = e & 2047; const float c = cb < 8 ? cin[cb * 2048 + k] : cctx[k]; sil[e] = silu_f(c); }
            __syncthreads();
            const int l = it >> 7, n0 = (it & 127) * 144, cg = tid % 36, ks = tid / 36;
            f32x4 acc[9];
#pragma unroll
            for (int cb = 0; cb < 9; ++cb) acc[cb] = (f32x4){0.f, 0.f, 0.f, 0.f};
            if (ks < 14) {
                const int klo = ks * 147, khi = (klo + 147) < 2048 ? (klo + 147) : 2048;
                const float* wp = aw + ((size_t)l * 2048 + klo) * NMOD + n0 + cg * 4;
#pragma unroll 7
                for (int k = klo; k < khi; ++k) { const f32x4 w = IN_LOAD((const f32x4*)wp); wp += NMOD;
#pragma unroll
                    for (int cb = 0; cb < 9; ++cb) acc[cb] += sil[cb * 2048 + k] * w; }
            }
            __syncthreads();
            if (ks < 14) {
#pragma unroll
                for (int cb = 0; cb < 9; ++cb) *(LAS f32x4*)(sil + (ks * 9 + cb) * 144 + cg * 4) = acc[cb];
            }
            __syncthreads();
            for (int o = tid; o < 9 * 144; o += 512) { const int cb = o / 144, n = o - cb * 144; float s = ab[l * NMOD + n0 + n];
#pragma unroll
                for (int k2 = 0; k2 < 14; ++k2) s += sil[(k2 * 9 + cb) * 144 + n];
                mods[((size_t)l * 9 + cb) * NMOD + n0 + n] = s; }
            __syncthreads();
        }
    }
    if (blockIdx.x == 0) {
        f32x2* r64 = WSP(f32x2, WS_ROPE); f32x2* r128 = r64 + 64 * 16;
        for (int e = tid; e < 64 * 16 + 64 * 32; e += 512) {
            int pos, i, q; if (e < 1024) { pos = e >> 4; i = e & 15; q = 16; } else { const int f = e - 1024; pos = f >> 5; i = f & 31; q = 32; }
            const float inv = __builtin_amdgcn_exp2f(-13.287712379549449f * (float)i / (float)q);
            const float rev = (float)pos * inv * 0.15915494309189535f; const float fr = rev - __builtin_rintf(rev);
            const f32x2 v = {__builtin_amdgcn_cosf(fr), __builtin_amdgcn_sinf(fr)};
            if (e < 1024) r64[e] = v; else r128[e - 1024] = v;
        }
    }
    for (int e = blockIdx.x * 512 + tid; e < 2 * 32 * 192 * 8; e += G * 512) { const int ls = e / (192 * 8), r = e - ls * 192 * 8;
        *(v4u*)(WSP(bf16, WS_WIN) + ((size_t)ls * NINP + NIN) * 64 + (size_t)r * 8) = (v4u){0u, 0u, 0u, 0u}; }
    wcopy_set<0>(lds, 0, 0, WCOPY_NPRO, blockIdx.x, G);
}

template <bool FIRST> __device__ __forceinline__ void norm_phase(const float* xA, const float* xB, int l, int k) {
    const int tid = opaque_tid(), lane = tid & 63, wave = tid >> 6;
    const float* mods = WSP(float, WS_MODS); bf16* H = WSP(bf16, WS_H); bf16* X = WSP(bf16, WS_X);
    const f32x4* g4 = (const f32x4*)(INP(I_NORMG) + (size_t)(l * 3 + k) * DM);
    typedef typename std::conditional<FIRST, f32x4, v2u>::type RawT;
    auto load_row = [&](int row, RawT (&r)[8]) {
        if constexpr (FIRST) { const f32x4* xr = (const f32x4*)((row < NCTX ? xA : xB) + (size_t)row * DM);
#pragma unroll
            for (int j = 0; j < 8; ++j) r[j] = xr[lane + 64 * j];
        } else { const v2u* xr = (const v2u*)(X + (size_t)row * DM);
#pragma unroll
            for (int j = 0; j < 8; ++j) r[j] = xr[lane + 64 * j]; }
    };
    for (int chunk = blockIdx.x * 8 + wave; chunk < NTOK / 8; chunk += gridDim.x * 8) {
        const int r0 = chunk * 8, cb = r0 < NCTX ? 8 : ((r0 - NCTX) >> 10);
        const f32x4* sh4 = (const f32x4*)(mods + ((size_t)l * 9 + cb) * NMOD + (size_t)(3 * k) * DM); const f32x4* sc4 = sh4 + DM / 4;
        RawT cur[8], nxt[8];
        load_row(r0, cur);
        f32x4 ga[8], sh[8];
#pragma unroll
        for (int j = 0; j < 8; ++j) { const int c = lane + 64 * j; ga[j] = g4[c] * (1.0f + sc4[c]); sh[j] = sh4[c]; }
#pragma unroll 1
        for (int i = 0; i < 8; ++i) { const int row = r0 + i;
            if (i < 7) load_row(row + 1, nxt);
            f32x4 v[8]; float ss = 0.f;
#pragma unroll
            for (int j = 0; j < 8; ++j) { if constexpr (FIRST) v[j] = cur[j]; else v[j] = b4f(cur[j]); ss += dot4(v[j]); }
            if constexpr (FIRST) { v2u* x8 = (v2u*)(X + (size_t)row * DM);
#pragma unroll
                for (int j = 0; j < 8; ++j) x8[lane + 64 * j] = pk4(v[j]); }
            const float rstd = 1.0f / sqrtf(wave_sum(ss) * (1.0f / DM) + EPS);
#pragma unroll
            for (int j = 0; j < 8; ++j) { const int c = lane + 64 * j; *(v2u*)(H + ((size_t)(c >> 4) * NTOK + row) * 64 + 4 * (c & 15)) = pk4((v[j] * rstd) * ga[j] + sh[j]); }
#pragma unroll
            for (int j = 0; j < 8; ++j) cur[j] = nxt[j];
        }
    }
}
__device__ __forceinline__ void final_phase(const Args& A) {
    const int tid = opaque_tid(), lane = tid & 63, wave = tid >> 6;
    const bf16* X = WSP(bf16, WS_X); const f32x4* g4 = (const f32x4*)INP(I_FNORM);
    const int row0 = blockIdx.x * 8 + wave, rstep = gridDim.x * 8;
    f32x4 gf[8];
#pragma unroll
    for (int j = 0; j < 8; ++j) gf[j] = g4[lane + 64 * j];
    v2u cur[8], nxt[8];
    if (row0 < NTOK) { const v2u* xr = (const v2u*)(X + (size_t)row0 * DM);
#pragma unroll
        for (int j = 0; j < 8; ++j) cur[j] = xr[lane + 64 * j]; }
    for (int row = row0; row < NTOK; row += rstep) {
        if (row + rstep < NTOK) { const v2u* xr = (const v2u*)(X + (size_t)(row + rstep) * DM);
#pragma unroll
            for (int j = 0; j < 8; ++j) nxt[j] = xr[lane + 64 * j]; }
        f32x4 v[8]; float ss = 0.f;
#pragma unroll
        for (int j = 0; j < 8; ++j) { v[j] = b4f(cur[j]); ss += dot4(v[j]); }
        const float rstd = 1.0f / sqrtf(wave_sum(ss) * (1.0f / DM) + EPS);
        f32x4* o = (f32x4*)(OUTP() + O_Y + (size_t)row * DM);
#pragma unroll
        for (int j = 0; j < 8; ++j) { const int c = lane + 64 * j; OUT_STORE(o + c, (v[j] * rstd) * gf[j]); }
#pragma unroll
        for (int j = 0; j < 8; ++j) cur[j] = nxt[j];
    }
}

__device__ __forceinline__ void post_phase(const Args& A, int l) {
    const int tid = opaque_tid(), lane = tid & 63, wave = tid >> 6, gw = blockIdx.x * 8 + wave, NGW = gridDim.x * 8;
    const bf16* MIX = WSP(bf16, WS_ACT);
    const f32x2* r64 = WSP(f32x2, WS_ROPE); const f32x2* r128 = r64 + 64 * 16;
    bf16 *CQN = WSP(bf16, WS_CQN), *CKVN = WSP(bf16, WS_CKVN), *KRC = WSP(bf16, WS_KRC), *KRL = WSP(bf16, WS_KRL), *NAQ = WSP(bf16, WS_NAQ), *NAKC = WSP(bf16, WS_NAKC), *NAVC = WSP(bf16, WS_NAVC),
         *NAKL = WSP(bf16, WS_NAKL), *NAVL = WSP(bf16, WS_NAVL), *GQ = WSP(bf16, WS_GQ), *GKC = WSP(bf16, WS_GKC), *GVC = WSP(bf16, WS_GVC), *GKL = WSP(bf16, WS_GKL), *GVL = WSP(bf16, WS_GVL);
    float* out = OUTP();
    const float* qn = INP(I_QNORM) + l * 512; const float* kvn = INP(I_KVNORM) + l * 256; const float* gqn = INP(I_GQN) + l * 128; const float* gkn = INP(I_GKN) + l * 128;
    const int hh = lane >> 5, i32 = lane & 31;
    const f32x4 qn0 = *(const f32x4*)(qn + lane * 4), qn1 = *(const f32x4*)(qn + 256 + lane * 4), kvn4 = *(const f32x4*)(kvn + lane * 4);
    float gq4[4], gk4[4];
#pragma unroll
    for (int q = 0; q < 4; ++q) { gq4[q] = gqn[q * 32 + i32]; gk4[q] = gkn[q * 32 + i32]; }
    struct RowIn { v2u q0, q1, kv; bf16 kr1, kr2, gq[2][4], gk[4]; f32x2 c64, c0, c1; };
    auto load_row = [&](int row, RowIn& R) {
        const bf16* mr = MIX + (size_t)row * NINP;
        R.q0 = *(const v2u*)(mr + lane * 4); R.q1 = *(const v2u*)(mr + 256 + lane * 4); R.kv = *(const v2u*)(mr + 512 + lane * 4);
        const int a = (lane >> 4) & 1, i = lane & 15; R.kr1 = mr[3328 + a * 32 + i]; R.kr2 = mr[3328 + a * 32 + 16 + i];
#pragma unroll
        for (int pp = 0; pp < 2; ++pp)
#pragma unroll
            for (int q = 0; q < 4; ++q) R.gq[pp][q] = mr[2304 + (2 * pp + hh) * 128 + q * 32 + i32];
#pragma unroll
        for (int q = 0; q < 4; ++q) R.gk[q] = mr[2816 + hh * 128 + q * 32 + i32];
        if (row >= NCTX) { const int t = (row - NCTX) & 1023; R.c64 = r64[(a ? (t & 63) : (t >> 6)) * 16 + i]; R.c0 = r128[(t >> 6) * 32 + i32]; R.c1 = r128[(t & 63) * 32 + i32]; }
    };
    auto b2f = [](bf16 v) { return __builtin_bit_cast(float, (unsigned)v << 16); };
    const bool bal = (NGW == NTOK / 8);
    for (int chunk0 = gw; chunk0 < NTOK / 8; chunk0 += NGW) {
        const int chunk = bal ? ((wave >> 2) & 1) * (NTOK / 16) + (int)blockIdx.x * 4 + (wave & 3) : chunk0;
        RowIn cur, nxt;
        load_row(chunk * 8, cur);
#pragma unroll 1
        for (int ri = 0; ri < 8; ++ri) { const int row = chunk * 8 + ri;
        if (ri < 7) load_row(row + 1, nxt);
        const bool ctx = row < NCTX;
        int b, t; size_t lrow = 0, orow = 0;
        if (ctx) { b = row >> 8; t = row & 255; orow = (size_t)(b * 2 + l) * 256 + t; } else { const int r2 = row - NCTX; b = r2 >> 10; t = r2 & 1023; lrow = (size_t)b * 1536 + 512 + t; }
        { const f32x4 q0 = b4f(cur.q0), q1 = b4f(cur.q1);
          const float rstd = 1.0f / sqrtf(wave_sum(dot4(q0) + dot4(q1)) * (1.0f / 512.0f) + EPS);
          *(v2u*)(CQN + ((size_t)(lane >> 4) * NTOK + row) * 64 + 4 * (lane & 15)) = pk4(q0 * rstd * qn0);
          *(v2u*)(CQN + ((size_t)(4 + (lane >> 4)) * NTOK + row) * 64 + 4 * (lane & 15)) = pk4(q1 * rstd * qn1); }
        { const f32x4 kv = b4f(cur.kv);
          const float rstd = 1.0f / sqrtf(wave_sum(dot4(kv)) * (1.0f / 256.0f) + EPS);
          const f32x4 y = kv * rstd * kvn4;
          if (ctx) OUT_STORE((f32x4*)(out + O_CKV + orow * 256 + lane * 4), y);
          *(v2u*)(CKVN + ((size_t)(lane >> 4) * NKVROWS + row) * 64 + 4 * (lane & 15)) = pk4(y); }
        if (lane < 32) { const int a = lane >> 4, i = lane & 15; const float x1 = b2f(cur.kr1), x2 = b2f(cur.kr2);
          if (ctx) { out[O_KR + orow * 64 + a * 32 + i] = x1; out[O_KR + orow * 64 + a * 32 + 16 + i] = x2; *(unsigned*)(KRC + (size_t)row * 64 + a * 32 + 2 * i) = pk2(x1, x2); }
          else { const f32x2 cs = cur.c64; *(unsigned*)(KRL + lrow * 64 + a * 32 + 2 * i) = pk2(x1 * cs.x - x2 * cs.y, x2 * cs.x + x1 * cs.y); } }
#pragma unroll
        for (int pp = 0; pp < 2; ++pp) { const int head = 2 * pp + hh; float x[4];
#pragma unroll
          for (int q = 0; q < 4; ++q) x[q] = b2f(cur.gq[pp][q]);
          const float rstd = 1.0f / sqrtf(half_sum((x[0] * x[0] + x[1] * x[1]) + (x[2] * x[2] + x[3] * x[3])) * (1.0f / 128.0f) + EPS);
#pragma unroll
          for (int q = 0; q < 4; ++q) x[q] = x[q] * rstd * gq4[q];
          if (!ctx) { const f32x2 c0 = cur.c0, c1 = cur.c1;
            const float y0 = x[0] * c0.x - x[1] * c0.y, y1 = x[1] * c0.x + x[0] * c0.y, y2 = x[2] * c1.x - x[3] * c1.y, y3 = x[3] * c1.x + x[2] * c1.y; x[0] = y0; x[1] = y1; x[2] = y2; x[3] = y3; }
#pragma unroll
          for (int q = 0; q < 4; ++q) GQ[(size_t)row * 512 + head * 128 + q * 32 + i32] = f2bf(x[q]); }
        { float x[4];
#pragma unroll
          for (int q = 0; q < 4; ++q) x[q] = b2f(cur.gk[q]);
          const float rstd = 1.0f / sqrtf(half_sum((x[0] * x[0] + x[1] * x[1]) + (x[2] * x[2] + x[3] * x[3])) * (1.0f / 128.0f) + EPS);
#pragma unroll
          for (int q = 0; q < 4; ++q) x[q] = x[q] * rstd * gk4[q];
          if (ctx) {
#pragma unroll
            for (int q = 0; q < 4; ++q) { out[O_GK + orow * 256 + hh * 128 + q * 32 + i32] = x[q]; GKC[(size_t)row * 256 + hh * 128 + q * 32 + i32] = f2bf(x[q]); }
          } else { const f32x2 c0 = cur.c0, c1 = cur.c1;
            const float y0 = x[0] * c0.x - x[1] * c0.y, y1 = x[1] * c0.x + x[0] * c0.y, y2 = x[2] * c1.x - x[3] * c1.y, y3 = x[3] * c1.x + x[2] * c1.y;
            bf16* d = GKL + lrow * 256 + hh * 128 + i32; d[0] = f2bf(y0); d[32] = f2bf(y1); d[64] = f2bf(y2); d[96] = f2bf(y3); } }
        cur = nxt;
        }
    }
    for (int r = gw; r < 4096; r += NGW) { const int b = r >> 9, pp = r & 511; const size_t src = (size_t)(b * 2 + l) * 512 + pp, lrow = (size_t)b * 1536 + pp;
        const int a = (lane >> 4) & 1, i = lane & 15; const float* s = INP(I_CKR) + src * 64;
        const f32x4 ckv = *(const f32x4*)(INP(I_CCKV) + src * 256 + lane * 4); const float k1 = s[a * 32 + i], k2 = s[a * 32 + 16 + i];
        const f32x4 nk0 = *(const f32x4*)(INP(I_CNAK) + src * 512 + lane * 4), nk1 = *(const f32x4*)(INP(I_CNAK) + src * 512 + 256 + lane * 4);
        const f32x4 nv0 = *(const f32x4*)(INP(I_CNAV) + src * 512 + lane * 4), nv1 = *(const f32x4*)(INP(I_CNAV) + src * 512 + 256 + lane * 4);
        const f32x4 gk = *(const f32x4*)(INP(I_CGK) + src * 256 + lane * 4), gv = *(const f32x4*)(INP(I_CGV) + src * 256 + lane * 4);
        *(v2u*)(CKVN + ((size_t)(lane >> 4) * NKVROWS + NTOK + r) * 64 + 4 * (lane & 15)) = pk4(ckv);
        if (lane < 32) *(unsigned*)(KRL + lrow * 64 + a * 32 + 2 * i) = pk2(k1, k2);
        *(v2u*)(NAKL + lrow * 512 + lane * 4) = pk4(nk0); *(v2u*)(NAKL + lrow * 512 + 256 + lane * 4) = pk4(nk1);
        *(v2u*)(NAVL + lrow * 512 + lane * 4) = pk4(nv0); *(v2u*)(NAVL + lrow * 512 + 256 + lane * 4) = pk4(nv1);
        *(v2u*)(GKL + lrow * 256 + lane * 4) = pk4(gk); *(v2u*)(GVL + lrow * 256 + lane * 4) = pk4(gv);
    }
}

#ifndef ATT_SD192
#define ATT_SD192 1
#endif
#ifndef ATT_SD128
#define ATT_SD128 1
#endif
#ifndef ATT_SDH
#define ATT_SDH 1
#endif
template <class F> __device__ __forceinline__ void queue_loop(char* lds, unsigned* qhead, int n, F&& unit) {
    volatile int* bc = (volatile int*)(lds + att::OFF_BC);
    for (;;) {
        if (opaque_tid() == 0) *bc = (int)__hip_atomic_fetch_add(qhead, 1u, __ATOMIC_RELAXED, __HIP_MEMORY_SCOPE_AGENT);
        __syncthreads();
        const int idx = __builtin_amdgcn_readfirstlane(*bc);
        if (idx >= n) break;
        unit(idx);
    }
    __syncthreads();
}
__device__ __forceinline__ void attn_phase(const Args& A, int l, char* lds, unsigned* qh) {
    queue_loop(lds, qh, 128, [&](int i) {
        const int tid = opaque_tid(), b = i >> 4, h = (i >> 2) & 3, qt = i & 3; const size_t qrow = (size_t)NCTX + b * 1024 + qt * 256, kr0 = (size_t)b * 1536;
        const int lo = qt == 2 ? 4 : (qt == 3 ? 8 : 0), nloc = (qt == 0 || qt == 3) ? 8 : 12;
        float* T = (float*)(lds + att::OFF_T); const float* rpb = INP(I_RPB) + (size_t)(l * 4 + h) * 15 * 31;
        for (int e = tid; e < 15 * 128; e += 512) { const int dr = e >> 7, dc = (e & 127) - 48; T[e] = (dc >= 0 && dc < 31) ? rpb[dr * 31 + dc] * 11.313708498984761f : 0.f; }
        if (tid < 128) ((float*)(lds + att::OFF_PEN))[tid] = (tid >= 63 && tid < 79) ? 0.f : -1e30f;
        __syncthreads();
        att::attn_unit<128, true, ATT_SDH, 4>(WSP(bf16, WS_NAQ) + qrow * 512 + h * 128, 512, WSP(bf16, WS_NAKL) + kr0 * 512 + h * 128, 512, nullptr, WSP(bf16, WS_NAVL) + kr0 * 512 + h * 128,
                                              WSP(bf16, WS_O), (int)qrow, 1024 + h * 128, 8 + nloc, 8, 512 + 64 * lo, 4 * qt, lo, lds); });
    queue_loop(lds, qh + 64, 128, [&](int i) {
        const int b = i >> 4, h = (i >> 2) & 3, qt = i & 3; const size_t qrow = (size_t)NCTX + b * 1024 + qt * 256, kr0 = (size_t)b * 1536;
        att::attn_unit<128, false, ATT_SD128, 8>(WSP(bf16, WS_GQ) + qrow * 512 + h * 128, 512, WSP(bf16, WS_GKL) + kr0 * 256 + (h >> 1) * 128, 256, nullptr, WSP(bf16, WS_GVL) + kr0 * 256 + (h >> 1) * 128,
                                                 WSP(bf16, WS_O), (int)qrow, 1536 + h * 128, 24, 24, 0, 0, 0, lds); });
    queue_loop(lds, qh + 128, 512, [&](int idx) {
        const bf16 *Qp, *Kp, *Rp, *Vp; int orow, ocol, NT;
        if (idx < 256) { const int b = idx >> 5, h = (idx >> 2) & 7, qt = idx & 3; const size_t qrow = (size_t)NCTX + b * 1024 + qt * 256, kr0 = (size_t)b * 1536;
            Qp = WSP(bf16, WS_QMLA) + qrow * NQ + h * 192; Kp = WSP(bf16, WS_KNL) + kr0 * 1024 + h * 128; Rp = WSP(bf16, WS_KRL) + kr0 * 64; Vp = WSP(bf16, WS_VML) + kr0 * 1024 + h * 128; orow = (int)qrow; ocol = h * 128; NT = 24; }
        else { const int i = idx - 256, b = i >> 3, h = i & 7; const size_t r0 = (size_t)b * 256;
            Qp = WSP(bf16, WS_QMLA) + r0 * NQ + h * 192; Kp = WSP(bf16, WS_KNC) + r0 * 1024 + h * 128; Rp = WSP(bf16, WS_KRC) + r0 * 64; Vp = WSP(bf16, WS_VMC) + r0 * 1024 + h * 128; orow = (int)r0; ocol = h * 128; NT = 4; }
        att::attn_unit<192, false, ATT_SD192, 8>(Qp, NQ, Kp, 1024, Rp, Vp, WSP(bf16, WS_O), orow, ocol, NT, NT, 0, 0, 0, lds); });
    queue_loop(lds, qh + 192, 256, [&](int idx) {
        const int i = idx & 127, b = i >> 2, h = i & 3; const size_t r0 = (size_t)b * 256;
        const bf16 *Qp, *Kp, *Vp; int ocol, ldk;
        if (idx < 128) { Qp = WSP(bf16, WS_NAQ) + r0 * 512 + h * 128; Kp = WSP(bf16, WS_NAKC) + r0 * 512 + h * 128; Vp = WSP(bf16, WS_NAVC) + r0 * 512 + h * 128; ocol = 1024 + h * 128; ldk = 512; }
        else { Qp = WSP(bf16, WS_GQ) + r0 * 512 + h * 128; Kp = WSP(bf16, WS_GKC) + r0 * 256 + (h >> 1) * 128; Vp = WSP(bf16, WS_GVC) + r0 * 256 + (h >> 1) * 128; ocol = 1536 + h * 128; ldk = 256; }
        att::attn_unit<128, false, ATT_SD128, 8>(Qp, 512, Kp, ldk, nullptr, Vp, WSP(bf16, WS_O), (int)r0, ocol, 4, 4, 0, 0, 0, lds); });
}

#ifndef REP_PRO
#define REP_PRO 1
#endif
#ifndef REP_NORM
#define REP_NORM 1
#endif
#ifndef REP_GU
#define REP_GU 1
#endif
#ifndef REP_WIN
#define REP_WIN 1
#endif
#ifndef REP_POST
#define REP_POST 1
#endif
#ifndef REP_QKV
#define REP_QKV 1
#endif
#ifndef REP_DOWN
#define REP_DOWN 1
#endif
#ifndef REP_WOUT
#define REP_WOUT 1
#endif
#ifndef REP_ATT
#define REP_ATT 1
#endif
#ifndef MIXM
#define MIXM true
#endif
#ifndef GP_ALIGN
#define GP_ALIGN true
#endif
#ifndef GP_SP2
#define GP_SP2 true
#endif
#define REPEAT(n) _Pragma("unroll 1") for (int rep_ = 0; rep_ < (n); ++rep_)
constexpr int NPH = 26;
__global__ void __launch_bounds__(512, 2) hybrid_fwd(Args A) {
    extern __shared__ __attribute__((aligned(16))) unsigned char lds[];
    LAS unsigned char* ldsl = (LAS unsigned char*)lds;
    const int tid = threadIdx.x;
    volatile LAS unsigned* misc = (volatile LAS unsigned*)(ldsl + LDS_MISC);
    if (tid < 8) misc[tid] = 0u;
    __syncthreads();
    const int lo = A.ph_lo, hi = A.ph_hi;
    XcdBarrier bar; bar.bar = nullptr; bar.x = 0; bar.st = misc;
    if (hi - lo > 1) bar = xcd_barrier_post(WSP(unsigned, WS_CTL) + CW_BAR, misc);
#define PH_BEGIN if (ph >= lo && ph < hi) {
#define PH_END   if (ph + 1 < hi) { XcdBarrier b2_ = bar; b2_.bar = WSP(unsigned, WS_CTL) + CW_BAR; asm volatile("" : "+s"(b2_.x)); xcd_barrier(b2_); } } ++ph;
    int ph = 0;
    const int G = gridDim.x;
#define bx opaque_bx()

    PH_BEGIN REPEAT(REP_PRO) { prologue_phase(A, ldsl); __syncthreads(); } PH_END

#pragma unroll 1
    for (int l = 0; l < 2; ++l) {
#pragma unroll 1
        for (int sub = 0; sub < 2; ++sub) {
            const bool first = (l == 0 && sub == 0);
            const int k = sub ? 2 : 0, lf = l * 2 + sub;
            PH_BEGIN REPEAT(REP_NORM) { if (first) norm_phase<true>(INP(I_XP), INP(I_XS) - (size_t)NCTX * DM, l, k); else norm_phase<false>(nullptr, nullptr, l, k); } PH_END
            PH_BEGIN REPEAT(REP_GU) {
                pg8::Gemm g = pg8::Gemm::make(WSP(bf16, WS_H), true, 0, WSP(bf16, WS_WGU) + (size_t)lf * 2 * FF * DM, true, 0, NTOK, 2 * FF, DM); pg8::StaticOrder S; S.init(NTOK, 2 * FF, G, bx);
                EpiSwiglu E{WSP(bf16, WS_ACT)};
                pg8::gemm_phase<EpiSwiglu, pg8::StaticOrder, GP_ALIGN, GP_SP2>(ldsl, g, S, E);
            } PH_END
            PH_BEGIN REPEAT(REP_DOWN) {
                pg8::Gemm g = pg8::Gemm::make(WSP(bf16, WS_ACT), true, 0, WSP(bf16, WS_WD) + (size_t)lf * DM * FF, true, 0, NTOK, DM, FF);
                pg8::StaticOrder S; S.init(NTOK, DM, G, bx);
                bf16* X = WSP(bf16, WS_X); bf16* Xo = rep_ ? WSP(bf16, WS_CQN) : X;   EpiResid E{X, Xo, WSP(float, WS_MODS) + (size_t)l * 9 * NMOD + (size_t)(3 * k + 2) * DM, 0.5f};
                pg8::gemm_phase<EpiResid, pg8::StaticOrder, GP_ALIGN, GP_SP2>(ldsl, g, S, E);
            } PH_END
            if (sub == 0) {
                PH_BEGIN REPEAT(REP_NORM) { norm_phase<false>(nullptr, nullptr, l, 1); } PH_END
                PH_BEGIN REPEAT(REP_WIN) {
                    pg8::Gemm g = pg8::Gemm::make(WSP(bf16, WS_H), true, 0, WSP(bf16, WS_WIN) + (size_t)l * NINP * DM, true, 0, NTOK, NINP, DM); pg8::StaticOrder S; S.init(NTOK, NINP, G, bx); S.mixm = MIXM && G == 256;
                    EpiMix E{WSP(bf16, WS_ACT), NINP, WSP(bf16, WS_NAQ), WSP(bf16, WS_NAKC), WSP(bf16, WS_NAVC), WSP(bf16, WS_NAKL), WSP(bf16, WS_NAVL), WSP(bf16, WS_GVC), WSP(bf16, WS_GVL),
                             OUTP() + O_NAK + (size_t)l * 256 * 512, OUTP() + O_NAV + (size_t)l * 256 * 512, OUTP() + O_GV + (size_t)l * 256 * 256};
                    pg8::gemm_phase<EpiMix, pg8::StaticOrder, GP_ALIGN, GP_SP2>(ldsl, g, S, E);
                    { const int rem = ((NTOK / 256) * (NINP / 256)) % G, c = bx; constexpr int NI = WCOPY_NTAIL - WCOPY_NTAIL / 11;
                      int v0 = 0, cnt = WCOPY_NTAIL, wg = c, nw = G;
                      if (rem) { if (c >= rem) { cnt = NI; wg = c - rem; nw = G - rem; } else { v0 = NI; cnt = WCOPY_NTAIL - NI; nw = rem; } }
                      wcopy_set<1>(ldsl, 2 * l + 1, v0, cnt, wg, nw); __syncthreads(); }
                } PH_END
                PH_BEGIN REPEAT(REP_POST) { post_phase(A, l); } PH_END
                PH_BEGIN REPEAT(REP_QKV) {
                    { pg8::Gemm g = pg8::Gemm::make(WSP(bf16, WS_CQN), true, 0, WSP(bf16, WS_WQB) + (size_t)l * NQ * 512, true, 0, NTOK, NQ, 512); pg8::StaticOrder S; S.init(NTOK, NQ, G, bx);
                      EpiQRope E{WSP(bf16, WS_QMLA), WSP(f32x2, WS_ROPE)};
                      pg8::gemm_phase<EpiQRope, pg8::StaticOrder, GP_ALIGN, GP_SP2>(ldsl, g, S, E); }
                    { pg8::Gemm g = pg8::Gemm::make(WSP(bf16, WS_CKVN), true, 0, WSP(bf16, WS_WKVB) + (size_t)l * 2048 * 256, true, 0, NKVROWS, 2048, 256); pg8::StaticOrder S; S.init(NKVROWS, 2048, G, G - 1 - bx);
                      EpiKV E{WSP(bf16, WS_KNC), WSP(bf16, WS_VMC), WSP(bf16, WS_KNL), WSP(bf16, WS_VML)};
                      pg8::gemm_phase<EpiKV, pg8::StaticOrder, GP_ALIGN, GP_SP2>(ldsl, g, S, E); }
                } PH_END
                PH_BEGIN REPEAT(REP_ATT) { attn_phase(A, l, (char*)lds, WSP(unsigned, WS_CTL) + (l ? CW_Q1 : CW_Q0) + 1024 * rep_); __syncthreads(); } PH_END
                PH_BEGIN REPEAT(REP_WOUT) {
                    pg8::Gemm g = pg8::Gemm::make(WSP(bf16, WS_O), true, 0, WSP(bf16, WS_WOUT) + (size_t)l * DM * DM, true, 0, NTOK, DM, DM); pg8::StaticOrder S; S.init(NTOK, DM, G, bx);
                    bf16* X = WSP(bf16, WS_X); bf16* Xo = rep_ ? WSP(bf16, WS_ACT) : X; EpiResid E{X, Xo, WSP(float, WS_MODS) + (size_t)l * 9 * NMOD + (size_t)5 * DM, 1.0f};
                    pg8::gemm_phase<EpiResid, pg8::StaticOrder, GP_ALIGN, GP_SP2>(ldsl, g, S, E);
                } PH_END
            }
        }
    }
    PH_BEGIN final_phase(A); PH_END
#undef PH_BEGIN
#undef PH_END
#undef bx
}

extern "C" void kernel_launch(void* const* d_in, const int* in_sizes, int n_in, void* d_out, int out_size, void* d_ws, size_t ws_size, hipStream_t stream) {
    static int grid = 0;
    if (grid == 0) {
        if (n_in != 26 || ws_size < WS_END) { fprintf(stderr, "kernel_launch: expected 26 inputs and >= %zu bytes of workspace, got %d inputs, %zu bytes; nothing launched\n", (size_t)WS_END, n_in, ws_size); grid = -1; return; }
        int dev = 0, cus = 0, per_cu = 0;
        if (hipGetDevice(&dev) != hipSuccess || hipDeviceGetAttribute(&cus, hipDeviceAttributeMultiprocessorCount, dev) != hipSuccess) { grid = -1; return; }
        if (hipFuncSetAttribute((const void*)hybrid_fwd, hipFuncAttributeMaxDynamicSharedMemorySize, LDS_BYTES) != hipSuccess) { fprintf(stderr, "kernel_launch: hipFuncSetAttribute failed\n"); grid = -1; return; }
        if (hipOccupancyMaxActiveBlocksPerMultiprocessor(&per_cu, (const void*)hybrid_fwd, 512, LDS_BYTES) != hipSuccess || per_cu < 1)
            fprintf(stderr, "kernel_launch: note: occupancy query reports %d workgroups per CU\n", per_cu);
        (void)hipGetLastError();
        grid = cus;
    }
    if (grid < 0) return;
    (void)hipMemsetAsync((char*)d_ws + WS_CTL, 0, CTL_ZERO_BYTES, stream);
    Args a{};
    for (int i = 0; i < 26; ++i) a.in[i] = (const float*)d_in[i];
    a.out = (float*)d_out; a.ws = (unsigned char*)d_ws;
#if MK_ONE_LAUNCH
    a.ph_lo = 0; a.ph_hi = NPH;
    hipLaunchKernelGGL(hybrid_fwd, dim3(grid), dim3(512), LDS_BYTES, stream, a);
#else
    for (int ph = 0; ph < NPH; ++ph) { a.ph_lo = ph; a.ph_hi = ph + 1; hipLaunchKernelGGL(hybrid_fwd, dim3(grid), dim3(512), LDS_BYTES, stream, a); }
#endif
    const hipError_t le = hipPeekAtLastError();
    if (le != hipSuccess) fprintf(stderr, "kernel_launch: launch failed: %s\n", hipGetErrorName(le));
}
```
